# Optimizing an MI355X kernel written in HIP

```python
import math
import jax, jax.numpy as jnp
from jax import lax
import numpy as np

D_MODEL = 1024
BATCH = 8
SEQ = 4096
DEPTH = 1

POOL_WINDOWS = (2, 4, 8, 16)
POOL_GROUPS = 4
POOL_GROUP_DIM = 128
POOL_WIDTH = POOL_GROUPS * POOL_GROUP_DIM
ATTN_HEADS = 8
ATTN_HEAD_DIM = 128
ATTN_WIDTH = ATTN_HEADS * ATTN_HEAD_DIM
KV_DIM = ATTN_HEAD_DIM
IDX_HEADS = 4
IDX_DIM = 64
TOPK_MAX = 256
Q_BLOCK = 128
N_BUCKETS = 32
MAX_DISTANCE = 128
N_MEM = 256
MEM_HEADS = 4
MEM_HEAD_DIM = 128
MEM_WIDTH = MEM_HEADS * MEM_HEAD_DIM
D_FF = -(-8 * D_MODEL // (3 * 256)) * 256
EPS = 1e-6

IN_SPLITS = (POOL_WIDTH, ATTN_WIDTH, KV_DIM, KV_DIM, IDX_HEADS * IDX_DIM, IDX_DIM, IDX_HEADS, D_MODEL, D_MODEL)
IN_WIDTH = sum(IN_SPLITS)

kernel_name = "hybrid_pool_dsa_gated_block"


def _rmsnorm(x, g):
    xf = x.astype(jnp.float32)
    y = xf * lax.rsqrt(jnp.mean(xf * xf, axis=-1, keepdims=True) + EPS)
    return (y * g.astype(jnp.float32)).astype(x.dtype)


def _t5_bucket(dist):
    n = jnp.maximum(dist, 0)
    max_exact = N_BUCKETS // 2
    nf = jnp.maximum(n, 1).astype(jnp.float32)
    large = max_exact + (jnp.log(nf / max_exact) / math.log(MAX_DISTANCE / max_exact)
                         * (N_BUCKETS - max_exact)).astype(jnp.int32)
    large = jnp.minimum(large, N_BUCKETS - 1)
    return jnp.where(n < max_exact, n, large)


def _pool_mixer(u, pool_w, pool_scale):
    B, S, _ = u.shape
    ug = u.reshape(B, S, POOL_GROUPS, POOL_GROUP_DIM).astype(jnp.float32)
    cs = jnp.concatenate([jnp.zeros((B, 1, POOL_GROUPS, POOL_GROUP_DIM), jnp.float32),
                          jnp.cumsum(ug, axis=1)], axis=1)
    win = jnp.array(POOL_WINDOWS, jnp.int32)
    t1 = jnp.arange(1, S + 1, dtype=jnp.int32)[:, None]
    lo = jnp.maximum(t1 - win[None, :], 0)
    cnt = jnp.minimum(t1, win[None, :]).astype(jnp.float32)
    g_idx = jnp.arange(POOL_GROUPS)[None, :]
    mean = (cs[:, 1:] - cs[:, lo, g_idx, :]) / cnt[None, :, :, None]
    pooled = (mean - ug).astype(u.dtype)
    mixed = jnp.einsum('bsgc,gcd->bsgd', pooled, pool_w)
    return mixed.reshape(B, S, POOL_WIDTH) * pool_scale


def _sparse_attention(q, k, v, q_idx, k_idx, w_idx, rel_bias_table):
    B, S = q.shape[:2]
    n_sel = min(TOPK_MAX, S // 4)
    nb = S // Q_BLOCK
    key_pos = jnp.arange(S, dtype=jnp.int32)
    idx_scale = IDX_DIM ** -0.5
    w_scale = IDX_HEADS ** -0.5
    attn_scale = ATTN_HEAD_DIM ** -0.5

    def blockify(a):
        return a.reshape((B, nb, Q_BLOCK) + a.shape[2:]).swapaxes(0, 1)

    def one_block(args):
        qb, qib, wb, start = args
        q_pos = start + jnp.arange(Q_BLOCK, dtype=jnp.int32)
        dots = jnp.einsum('bthd,bsd->bths', qib, k_idx).astype(jnp.float32) * idx_scale
        score = jnp.einsum('bths,bth->bts', jax.nn.relu(dots), wb.astype(jnp.float32) * w_scale)
        causal = key_pos[None, :] <= q_pos[:, None]
        score = jnp.where(causal[None], score, -jnp.inf)
        _, sel = lax.top_k(score, n_sel)
        valid = sel <= q_pos[None, :, None]
        kg = jax.vmap(lambda kb, ib: kb[ib])(k, sel)
        vg = jax.vmap(lambda vb, ib: vb[ib])(v, sel)
        logits = jnp.einsum('bthd,btkd->bhtk', qb, kg).astype(jnp.float32) * attn_scale
        bias = rel_bias_table[_t5_bucket(q_pos[None, :, None] - sel)]
        logits = logits + jnp.moveaxis(bias, -1, 1).astype(jnp.float32)
        logits = jnp.where(valid[:, None], logits, -jnp.inf)
        p = jax.nn.softmax(logits, axis=-1).astype(vg.dtype)
        return jnp.einsum('bhtk,btkd->bthd', p, vg)

    starts = jnp.arange(nb, dtype=jnp.int32) * Q_BLOCK
    out = lax.map(one_block, (blockify(q), blockify(q_idx), blockify(w_idx), starts))
    return out.swapaxes(0, 1).reshape(B, S, ATTN_HEADS * ATTN_HEAD_DIM)


def _mixer_sublayer(h, w_in, pool_w, pool_scale, w_proj_pool, w_proj_attn, rel_bias_table, w_out):
    B, S, _ = h.shape
    proj = h @ w_in
    offs = np.cumsum(IN_SPLITS)[:-1].tolist()
    u_pool, q, k, v, q_idx, k_idx, w_idx, g_pool, g_attn = jnp.split(proj, offs, axis=-1)
    a = _pool_mixer(u_pool, pool_w, pool_scale) @ w_proj_pool
    att = _sparse_attention(q.reshape(B, S, ATTN_HEADS, ATTN_HEAD_DIM), k, v,
                            q_idx.reshape(B, S, IDX_HEADS, IDX_DIM), k_idx, w_idx,
                            rel_bias_table)
    b = att @ w_proj_attn
    merged = jax.nn.sigmoid(g_pool) * a + jax.nn.sigmoid(g_attn) * b
    return merged @ w_out


def _memory_cross_attention(h, mem, norm_mem_kv, w_q_mem, w_kv_mem, w_o_mem):
    B, S, _ = h.shape
    q = (h @ w_q_mem).reshape(B, S, MEM_HEADS, MEM_HEAD_DIM)
    kv = _rmsnorm(mem, norm_mem_kv) @ w_kv_mem
    k, v = jnp.split(kv, 2, axis=-1)
    k = k.reshape(B, N_MEM, MEM_HEADS, MEM_HEAD_DIM)
    v = v.reshape(B, N_MEM, MEM_HEADS, MEM_HEAD_DIM)
    logits = jnp.einsum('bshd,bmhd->bhsm', q, k).astype(jnp.float32) * MEM_HEAD_DIM ** -0.5
    p = jax.nn.softmax(logits, axis=-1).astype(v.dtype)
    o = jnp.einsum('bhsm,bmhd->bshd', p, v).reshape(B, S, MEM_WIDTH)
    return o @ w_o_mem


def _swiglu(h, w_gate_up, w_down):
    g, u = jnp.split(h @ w_gate_up, 2, axis=-1)
    return (jax.nn.silu(g) * u) @ w_down


def setup_inputs(seed: int = 0) -> dict:
    key = jax.random.key(seed)
    ks = jax.random.split(key, 24)
    f32 = jnp.float32

    def w(k, shape, fan_in):
        return jax.random.normal(k, shape, f32) * fan_in ** -0.5

    def gain(k, n):
        return 1.0 + 0.02 * jax.random.normal(k, (n,), f32)

    return {
        "x": jax.random.normal(ks[0], (BATCH, SEQ, D_MODEL), f32),
        "mem": jax.random.normal(ks[1], (BATCH, N_MEM, D_MODEL), f32),
        "norm_mix_pre": gain(ks[2], D_MODEL),
        "norm_mix_post": gain(ks[3], D_MODEL),
        "w_in": w(ks[4], (D_MODEL, IN_WIDTH), D_MODEL),
        "pool_w": w(ks[5], (POOL_GROUPS, POOL_GROUP_DIM, POOL_GROUP_DIM), POOL_GROUP_DIM),
        "pool_scale": gain(ks[6], POOL_WIDTH),
        "w_proj_pool": w(ks[7], (POOL_WIDTH, D_MODEL), POOL_WIDTH),
        "w_proj_attn": w(ks[8], (ATTN_WIDTH, D_MODEL), ATTN_WIDTH),
        "rel_bias_table": 0.5 * jax.random.normal(ks[9], (N_BUCKETS, ATTN_HEADS), f32),
        "w_out": w(ks[10], (D_MODEL, D_MODEL), D_MODEL),
        "norm_mem_pre": gain(ks[11], D_MODEL),
        "norm_mem_kv": gain(ks[12], D_MODEL),
        "norm_mem_post": gain(ks[13], D_MODEL),
        "w_q_mem": w(ks[14], (D_MODEL, MEM_WIDTH), D_MODEL),
        "w_kv_mem": w(ks[15], (D_MODEL, 2 * MEM_WIDTH), D_MODEL),
        "w_o_mem": w(ks[16], (MEM_WIDTH, D_MODEL), MEM_WIDTH),
        "norm_ffn_pre": gain(ks[17], D_MODEL),
        "norm_ffn_post": gain(ks[18], D_MODEL),
        "w_gate_up": w(ks[19], (D_MODEL, 2 * D_FF), D_MODEL),
        "w_down": w(ks[20], (D_FF, D_MODEL), D_FF),
    }


def reference(x, mem, norm_mix_pre, norm_mix_post, w_in, pool_w, pool_scale, w_proj_pool,
              w_proj_attn, rel_bias_table, w_out, norm_mem_pre, norm_mem_kv, norm_mem_post,
              w_q_mem, w_kv_mem, w_o_mem, norm_ffn_pre, norm_ffn_post, w_gate_up, w_down):
    for _ in range(DEPTH):
        h = _rmsnorm(x, norm_mix_pre)
        x = x + _rmsnorm(_mixer_sublayer(h, w_in, pool_w, pool_scale, w_proj_pool,
                                         w_proj_attn, rel_bias_table, w_out), norm_mix_post)
        h = _rmsnorm(x, norm_mem_pre)
        x = x + _rmsnorm(_memory_cross_attention(h, mem, norm_mem_kv, w_q_mem, w_kv_mem, w_o_mem),
                         norm_mem_post)
        h = _rmsnorm(x, norm_ffn_pre)
        x = x + _rmsnorm(_swiglu(h, w_gate_up, w_down), norm_ffn_post)
    return x
```

```cpp
#include <hip/hip_runtime.h>
#include <cstdio>
#include <cstdint>

#define LAS __attribute__((address_space(3)))
typedef unsigned short bf16_t;
typedef short bf16x8 __attribute__((ext_vector_type(8)));
typedef float f32x4 __attribute__((ext_vector_type(4)));
typedef float f32x2 __attribute__((ext_vector_type(2)));
typedef unsigned u32x4 __attribute__((ext_vector_type(4)));
typedef unsigned u32x2 __attribute__((ext_vector_type(2)));
typedef __bf16 bf16x2_t __attribute__((ext_vector_type(2)));

constexpr int NWAVES = 8, NTHR = 512;
constexpr int BATCH = 8, SEQ = 4096, DM = 1024, M = BATCH * SEQ;
constexpr int NMEM = 256, MMEM = BATCH * NMEM;
constexpr int DFF = 2816;
constexpr int IN_W = 4164, IN_PAD = 4352;
constexpr float EPS = 1e-6f;

constexpr size_t MiB = 1u << 20;
constexpr size_t WS_CTL = 0, CTL_ZERO_BYTES = 64 * 1024;
constexpr size_t WS_WIN = 1 * MiB;
constexpr size_t WS_WEFF = 10 * MiB;
constexpr size_t WS_WPA = 11 * MiB;
constexpr size_t WS_WOUT = 13 * MiB;
constexpr size_t WS_WQ = 15 * MiB;
constexpr size_t WS_WKV = 16 * MiB;
constexpr size_t WS_WO = 18 * MiB;
constexpr size_t WS_WGU = 19 * MiB;
constexpr size_t WS_WDN = 30 * MiB;
constexpr size_t WS_MEMN = 36 * MiB;
constexpr size_t WS_KVM = 40 * MiB;
constexpr size_t WS_BM = 44 * MiB;
constexpr size_t WS_H = 64 * MiB;
constexpr size_t WS_U = 128 * MiB;
constexpr size_t WS_Q = 160 * MiB;
constexpr size_t WS_KV = 224 * MiB;
constexpr size_t WS_QI = 240 * MiB;
constexpr size_t WS_KI = 256 * MiB;
constexpr size_t WS_GP = 272 * MiB;
constexpr size_t WS_GA = 336 * MiB;
constexpr size_t WS_PL = 400 * MiB;
constexpr size_t WS_AB = 432 * MiB;
constexpr size_t WS_MG = 128 * MiB;
constexpr size_t WS_MIX = 192 * MiB;
constexpr size_t WS_QM = 256 * MiB;
constexpr size_t WS_OM = 288 * MiB;
constexpr size_t WS_ACT = 320 * MiB;
constexpr size_t WS_END = 496 * MiB;

constexpr int CW_BAR = 1024;

constexpr int RING_BYTES = 131072;
constexpr int LDSCTL_OFF = RING_BYTES, MISC_OFF = LDSCTL_OFF + 320;
constexpr int LDS_BYTES = 147456;

__device__ __forceinline__ unsigned cvtpk(float lo, float hi) { f32x2 v = {lo, hi}; bf16x2_t b = __builtin_convertvector(v, bf16x2_t); return __builtin_bit_cast(unsigned, b); }
__device__ __forceinline__ bf16_t f2bf(float f) { return (bf16_t)(cvtpk(f, 0.f) & 0xffffu); }
__device__ __forceinline__ float bf2f(bf16_t b) { return __uint_as_float((unsigned)b << 16); }
__device__ __forceinline__ float bflo(unsigned w) { return __uint_as_float(w << 16); }
__device__ __forceinline__ float bfhi(unsigned w) { return __uint_as_float(w & 0xffff0000u); }
__device__ __forceinline__ float wave_sum(float v) {
#pragma unroll
    for (int o = 1; o < 64; o <<= 1) v += __shfl_xor(v, o);
    return v;
}
__device__ __forceinline__ float wave_max(float v) {
#pragma unroll
    for (int o = 1; o < 64; o <<= 1) v = fmaxf(v, __shfl_xor(v, o));
    return v;
}
__device__ __forceinline__ float sigmoidf_(float x) { return 1.f / (1.f + __expf(-x)); }

#define XB_TMO      128
#define XB_XCNT(j)  (256  + 64 * (j))
#define XB_XSUB(j)  (1280 + 64 * (j))
#define XB_XGEN(j)  (2304 + 64 * (j))
#define XB_TOP      3328
#define XB_TOPGEN   3392
#define XCD_BAR_WORDS 3456
#define XB_SPIN_CAP (1u << 22)

__device__ __forceinline__ unsigned xb_ld(unsigned* p)              { return __hip_atomic_load(p, __ATOMIC_RELAXED, __HIP_MEMORY_SCOPE_AGENT); }
__device__ __forceinline__ unsigned xb_add(unsigned* p, unsigned v) { return __hip_atomic_fetch_add(p, v, __ATOMIC_RELAXED, __HIP_MEMORY_SCOPE_AGENT); }
__device__ __forceinline__ unsigned xb_xcc_id() { return (unsigned)__builtin_amdgcn_s_getreg((3 << 11) | 20) & 0xFu; }
#define XB_SPIN(cond, bar) do { unsigned _sp = 0; while (cond) { __builtin_amdgcn_s_sleep(1); \
    if ((++_sp & 255u) == 0u) { if (xb_ld(&(bar)[XB_TMO])) break; if (_sp > XB_SPIN_CAP) { atomicAdd(&(bar)[XB_TMO], 1u); break; } } } } while (0)

struct XcdBarrier { unsigned* bar; unsigned x; volatile LAS unsigned* st; };

__device__ __forceinline__ XcdBarrier xcd_barrier_post(unsigned* bar, volatile LAS unsigned* st) {
    XcdBarrier b; b.bar = bar; b.x = xb_xcc_id(); b.st = st;
    if (threadIdx.x == 0) (void)xb_add(&bar[XB_XCNT(b.x)], 1u);
    return b;
}
__device__ __forceinline__ void xcd_barrier_complete(unsigned* bar, unsigned x, unsigned& nloc, unsigned& nx) {
    const unsigned G = gridDim.x * gridDim.y * gridDim.z;
    unsigned sum, cnt, mine, sp = 0u;
    for (;;) {
        sum = 0u; cnt = 0u; mine = 0u;
#pragma unroll
        for (unsigned j = 0; j < 16; ++j) { const unsigned c = xb_ld(&bar[XB_XCNT(j)]); sum += c; cnt += (c > 0u) ? 1u : 0u; mine = (j == x) ? c : mine; }
        if (sum == G) break;
        __builtin_amdgcn_s_sleep(1);
        if ((++sp & 255u) == 0u) { if (xb_ld(&bar[XB_TMO])) break; if (sp > XB_SPIN_CAP) { atomicAdd(&bar[XB_TMO], 1u); break; } }
    }
    nloc = mine > 0u ? mine : 1u; nx = cnt > 0u ? cnt : 1u;
}
__device__ __forceinline__ void xcd_barrier(const XcdBarrier& b) {
    asm volatile("s_waitcnt vmcnt(0)" ::: "memory");
    __syncthreads();
    if (threadIdx.x == 0) {
        unsigned* bar = b.bar;
        __builtin_amdgcn_s_waitcnt(0);
        unsigned nloc = b.st[0], nx = b.st[1];
        if (nloc == 0u) { xcd_barrier_complete(bar, b.x, nloc, nx); b.st[0] = nloc; b.st[1] = nx; }
        const unsigned old = xb_add(&bar[XB_XSUB(b.x)], 1u);
        const unsigned gen = old / nloc;
        if (old + 1u == (gen + 1u) * nloc) {
            __builtin_amdgcn_fence(__ATOMIC_RELEASE, "agent");
            asm volatile("s_waitcnt vmcnt(0)" ::: "memory");
            const unsigned og = xb_add(&bar[XB_TOP], 1u);
            const unsigned tg = og / nx;
            if (og + 1u == (tg + 1u) * nx) xb_add(&bar[XB_TOPGEN], 1u);
            else XB_SPIN(xb_ld(&bar[XB_TOPGEN]) == tg, bar);
            __builtin_amdgcn_fence(__ATOMIC_ACQUIRE, "agent");
            xb_add(&bar[XB_XGEN(b.x)], 1u);
            asm volatile("s_waitcnt vmcnt(0)" ::: "memory");
        } else {
            XB_SPIN(xb_ld(&bar[XB_XGEN(b.x)]) == gen, bar);
            __builtin_amdgcn_fence(__ATOMIC_ACQUIRE, "agent");
            asm volatile("s_waitcnt vmcnt(0)" ::: "memory");
        }
    }
    __syncthreads();
}

namespace pg8 {
constexpr int BM = 256, HALF = 128, NXCD = 8, WGM = 8;
struct Unit { int pm, pn; };
struct Gemm { const bf16_t* A; const bf16_t* Bt; int M, N, K; };
struct StaticOrder {
    int nM, nN, nwg, G, c;
    __device__ void init(int M_, int N_, int G_, int c_) { nM = M_ / BM; nN = N_ / BM; nwg = nM * nN; G = G_; c = c_; }
    __device__ bool next(int i, Unit& u) const {
        const long L = (long)i * G + c; if (L >= nwg) return false;
        int wgid = (int)L; { const int q = nwg / NXCD, r = nwg % NXCD, xcd = wgid % NXCD, off = wgid / NXCD; wgid = (xcd < r ? xcd * (q + 1) : r * (q + 1) + (xcd - r) * q) + off; }
        const int nig = WGM * nN, gid = wgid / nig, fm = gid * WGM, gsz = (nM - fm) < WGM ? (nM - fm) : WGM;
        u.pm = fm + ((wgid % nig) % gsz); u.pn = (wgid % nig) / gsz; return true;
    }
};
template <class Epi>
__device__ __forceinline__ void gemm_simple(const Gemm g, const StaticOrder& S, const Epi& E) {
    const int tid = threadIdx.x, wid = __builtin_amdgcn_readfirstlane(tid >> 6), lane = tid & 63, wr = wid >> 2, wc = wid & 3, fr = lane & 15, fq = lane >> 4;
    const int K = g.K;
    Unit u;
    for (int i = 0; S.next(i, u); ++i) {
        f32x4 acc[2][2][4][2];
#pragma unroll
        for (int a = 0; a < 2; ++a)
#pragma unroll
            for (int b = 0; b < 2; ++b)
#pragma unroll
                for (int m = 0; m < 4; ++m)
#pragma unroll
                    for (int n = 0; n < 2; ++n) acc[a][b][m][n] = (f32x4){0.f, 0.f, 0.f, 0.f};
        const bf16_t* Ab = g.A + (size_t)(u.pm * BM + wr * 64 + fr) * K + fq * 8;
        const bf16_t* Bb = g.Bt + (size_t)(u.pn * BM + wc * 32 + fr) * K + fq * 8;
        for (int kk = 0; kk < K; kk += 32) {
            bf16x8 Bf[2][2];
#pragma unroll
            for (int b = 0; b < 2; ++b)
#pragma unroll
                for (int n = 0; n < 2; ++n) Bf[b][n] = *(const bf16x8*)(Bb + (size_t)(b * HALF + n * 16) * K + kk);
#pragma unroll
            for (int a = 0; a < 2; ++a) {
                bf16x8 At[4];
#pragma unroll
                for (int m = 0; m < 4; ++m) At[m] = *(const bf16x8*)(Ab + (size_t)(a * HALF + m * 16) * K + kk);
#pragma unroll
                for (int b = 0; b < 2; ++b)
#pragma unroll
                    for (int m = 0; m < 4; ++m)
#pragma unroll
                        for (int n = 0; n < 2; ++n) acc[a][b][m][n] = __builtin_amdgcn_mfma_f32_16x16x32_bf16(Bf[b][n], At[m], acc[a][b][m][n], 0, 0, 0);
            }
        }
        E(acc, u, wr, wc, fr, fq);
    }
}
__device__ __forceinline__ void st_bf16x4(bf16_t* p, f32x4 v) { u32x2 w; w.x = cvtpk(v[0], v[1]); w.y = cvtpk(v[2], v[3]); *(u32x2*)p = w; }

struct EpiBf {
    bf16_t* O; int ldc;
    __device__ __forceinline__ void operator()(const f32x4 (&acc)[2][2][4][2], const Unit& u, int wr, int wc, int fr, int fq) const {
#pragma unroll
        for (int ai = 0; ai < 2; ++ai)
#pragma unroll
            for (int m = 0; m < 4; ++m) {
                const size_t row = (size_t)(u.pm * BM + ai * HALF + wr * 64 + m * 16 + fr);
#pragma unroll
                for (int bj = 0; bj < 2; ++bj)
#pragma unroll
                    for (int n = 0; n < 2; ++n) st_bf16x4(O + row * ldc + u.pn * BM + bj * HALF + wc * 32 + n * 16 + 4 * fq, acc[ai][bj][m][n]);
            }
    }
};
struct EpiP1 {
    bf16_t *U, *Q, *KV, *QI, *KI, *GP, *GA;
    __device__ __forceinline__ void operator()(const f32x4 (&acc)[2][2][4][2], const Unit& u, int wr, int wc, int fr, int fq) const {
        const int pn = u.pn; bf16_t* base; int ldc, c0;
        if (pn < 2) { base = U; ldc = 512; c0 = pn * 256; }
        else if (pn < 6) { base = Q; ldc = 1024; c0 = (pn - 2) * 256; }
        else if (pn == 6) { base = KV; ldc = 256; c0 = 0; }
        else if (pn == 7) { base = QI; ldc = 256; c0 = 0; }
        else if (pn == 8) { base = KI; ldc = 256; c0 = 0; }
        else if (pn < 13) { base = GP; ldc = 1024; c0 = (pn - 9) * 256; }
        else { base = GA; ldc = 1024; c0 = (pn - 13) * 256; }
#pragma unroll
        for (int ai = 0; ai < 2; ++ai)
#pragma unroll
            for (int m = 0; m < 4; ++m) {
                const size_t row = (size_t)(u.pm * BM + ai * HALF + wr * 64 + m * 16 + fr);
#pragma unroll
                for (int bj = 0; bj < 2; ++bj)
#pragma unroll
                    for (int n = 0; n < 2; ++n) st_bf16x4(base + row * ldc + c0 + bj * HALF + wc * 32 + n * 16 + 4 * fq, acc[ai][bj][m][n]);
            }
    }
};
struct EpiMerge {
    const bf16_t *AB, *GP, *GA; bf16_t* MG;
    __device__ __forceinline__ void operator()(const f32x4 (&acc)[2][2][4][2], const Unit& u, int wr, int wc, int fr, int fq) const {
#pragma unroll
        for (int ai = 0; ai < 2; ++ai)
#pragma unroll
            for (int m = 0; m < 4; ++m) {
                const size_t row = (size_t)(u.pm * BM + ai * HALF + wr * 64 + m * 16 + fr);
#pragma unroll
                for (int bj = 0; bj < 2; ++bj)
#pragma unroll
                    for (int n = 0; n < 2; ++n) {
                        const size_t off = row * 1024 + u.pn * BM + bj * HALF + wc * 32 + n * 16 + 4 * fq;
                        const u32x2 a = *(const u32x2*)(AB + off), gp = *(const u32x2*)(GP + off), ga = *(const u32x2*)(GA + off);
                        const f32x4 b = acc[ai][bj][m][n]; f32x4 o;
                        o[0] = sigmoidf_(bflo(gp.x)) * bflo(a.x) + sigmoidf_(bflo(ga.x)) * b[0];
                        o[1] = sigmoidf_(bfhi(gp.x)) * bfhi(a.x) + sigmoidf_(bfhi(ga.x)) * b[1];
                        o[2] = sigmoidf_(bflo(gp.y)) * bflo(a.y) + sigmoidf_(bflo(ga.y)) * b[2];
                        o[3] = sigmoidf_(bfhi(gp.y)) * bfhi(a.y) + sigmoidf_(bfhi(ga.y)) * b[3];
                        st_bf16x4(MG + off, o);
                    }
            }
    }
};
struct EpiSwiglu {
    bf16_t* ACT;
    __device__ __forceinline__ void operator()(const f32x4 (&acc)[2][2][4][2], const Unit& u, int wr, int wc, int fr, int fq) const {
#pragma unroll
        for (int ai = 0; ai < 2; ++ai)
#pragma unroll
            for (int m = 0; m < 4; ++m) {
                const size_t row = (size_t)(u.pm * BM + ai * HALF + wr * 64 + m * 16 + fr);
#pragma unroll
                for (int n = 0; n < 2; ++n) {
                    const f32x4 gt = acc[ai][0][m][n], up = acc[ai][1][m][n]; f32x4 o;
#pragma unroll
                    for (int i = 0; i < 4; ++i) o[i] = gt[i] * sigmoidf_(gt[i]) * up[i];
                    st_bf16x4(ACT + row * DFF + u.pn * HALF + wc * 32 + n * 16 + 4 * fq, o);
                }
            }
    }
};
}

struct Args { const float* in[21]; float* out; unsigned char* ws; };

__device__ __forceinline__ void tr_item(const float* W, int ldw, int c0, int ncols, int K, bf16_t* WT, int r0, float* scr, int kb, int nb, int lane) {
    const int k0 = 64 * kb, n0 = 32 * nb;
#pragma unroll 8
    for (int i = 0; i < 32; ++i) { const int kk = 2 * i + (lane >> 5); const int nn = n0 + (lane & 31);
        scr[kk * 33 + (lane & 31)] = nn < ncols ? W[(size_t)(k0 + kk) * ldw + c0 + nn] : 0.f; }
    asm volatile("s_waitcnt lgkmcnt(0)" ::: "memory");
    const int c = lane & 7;
#pragma unroll
    for (int j = 0; j < 4; ++j) { const int n = (lane >> 3) + 8 * j; const float* s = scr + (8 * c) * 33 + n;
        u32x4 o; o.x = cvtpk(s[0 * 33], s[1 * 33]); o.y = cvtpk(s[2 * 33], s[3 * 33]); o.z = cvtpk(s[4 * 33], s[5 * 33]); o.w = cvtpk(s[6 * 33], s[7 * 33]);
        *(u32x4*)(WT + (size_t)(r0 + n0 + n) * K + k0 + 8 * c) = o; }
    asm volatile("s_waitcnt lgkmcnt(0)" ::: "memory");
}
__device__ __forceinline__ void rms_row_to_bf16(const float* xrow, const float* g, bf16_t* orow, int lane) {
    f32x4 v[4]; float s = 0.f;
#pragma unroll
    for (int j = 0; j < 4; ++j) { v[j] = *(const f32x4*)(xrow + 4 * lane + 256 * j); s += (v[j][0] * v[j][0] + v[j][1] * v[j][1]) + (v[j][2] * v[j][2] + v[j][3] * v[j][3]); }
    const float rstd = rsqrtf(wave_sum(s) * (1.f / DM) + EPS);
#pragma unroll
    for (int j = 0; j < 4; ++j) { const f32x4 gg = *(const f32x4*)(g + 4 * lane + 256 * j);
        u32x2 w; w.x = cvtpk(v[j][0] * rstd * gg[0], v[j][1] * rstd * gg[1]); w.y = cvtpk(v[j][2] * rstd * gg[2], v[j][3] * rstd * gg[3]);
        *(u32x2*)(orow + 4 * lane + 256 * j) = w; }
}
__device__ __forceinline__ void res_norm_row(const float* xin, const bf16_t* mix, const float* gpost, float* xo, const float* gpre, bf16_t* h, int lane) {
    f32x4 mv[4]; float s = 0.f;
#pragma unroll
    for (int j = 0; j < 4; ++j) { const u32x2 w = *(const u32x2*)(mix + 4 * lane + 256 * j); mv[j] = (f32x4){bflo(w.x), bfhi(w.x), bflo(w.y), bfhi(w.y)};
        s += (mv[j][0] * mv[j][0] + mv[j][1] * mv[j][1]) + (mv[j][2] * mv[j][2] + mv[j][3] * mv[j][3]); }
    const float rstd = rsqrtf(wave_sum(s) * (1.f / DM) + EPS);
    f32x4 xv[4]; float s2 = 0.f;
#pragma unroll
    for (int j = 0; j < 4; ++j) { const f32x4 gg = *(const f32x4*)(gpost + 4 * lane + 256 * j); const f32x4 xi = *(const f32x4*)(xin + 4 * lane + 256 * j);
        xv[j] = xi + mv[j] * rstd * gg; *(f32x4*)(xo + 4 * lane + 256 * j) = xv[j];
        s2 += (xv[j][0] * xv[j][0] + xv[j][1] * xv[j][1]) + (xv[j][2] * xv[j][2] + xv[j][3] * xv[j][3]); }
    if (h) {
        const float r2 = rsqrtf(wave_sum(s2) * (1.f / DM) + EPS);
#pragma unroll
        for (int j = 0; j < 4; ++j) { const f32x4 gg = *(const f32x4*)(gpre + 4 * lane + 256 * j);
            u32x2 w; w.x = cvtpk(xv[j][0] * r2 * gg[0], xv[j][1] * r2 * gg[1]); w.y = cvtpk(xv[j][2] * r2 * gg[2], xv[j][3] * r2 * gg[3]);
            *(u32x2*)(h + 4 * lane + 256 * j) = w; }
    }
}
__device__ __forceinline__ unsigned fkey(float f) { const unsigned b = __float_as_uint(f); return (b & 0x80000000u) ? ~b : (b | 0x80000000u); }

__global__ void __launch_bounds__(NTHR, 2) fwd_kernel(Args args) {
    extern __shared__ __attribute__((aligned(16))) unsigned char lds[];
    const int tid = threadIdx.x, lane = tid & 63, wave = __builtin_amdgcn_readfirstlane(tid >> 6);
    const int G = gridDim.x, bid = blockIdx.x;
    unsigned char* ws = args.ws;
    unsigned* ctl = (unsigned*)(ws + WS_CTL);
    for (int u = tid; u < (LDS_BYTES - LDSCTL_OFF) / 4; u += NTHR) ((unsigned*)(lds + LDSCTL_OFF))[u] = 0u;
    __syncthreads();
    XcdBarrier bar = xcd_barrier_post(ctl + CW_BAR, (volatile LAS unsigned*)((LAS unsigned char*)lds + MISC_OFF + 32));

    const float* x = args.in[0]; const float* mem = args.in[1];
    const float* g_mix_pre = args.in[2]; const float* g_mix_post = args.in[3];
    const float* w_in = args.in[4]; const float* pool_w = args.in[5]; const float* pool_scale = args.in[6];
    const float* w_proj_pool = args.in[7]; const float* w_proj_attn = args.in[8]; const float* rel_bias = args.in[9];
    const float* w_out = args.in[10]; const float* g_mem_pre = args.in[11]; const float* g_mem_kv = args.in[12]; const float* g_mem_post = args.in[13];
    const float* w_q_mem = args.in[14]; const float* w_kv_mem = args.in[15]; const float* w_o_mem = args.in[16];
    const float* g_ffn_pre = args.in[17]; const float* g_ffn_post = args.in[18]; const float* w_gate_up = args.in[19]; const float* w_down = args.in[20];
    float* out = args.out;
    bf16_t* Win_t = (bf16_t*)(ws + WS_WIN); bf16_t* Weff_t = (bf16_t*)(ws + WS_WEFF); bf16_t* Wpa_t = (bf16_t*)(ws + WS_WPA); bf16_t* Wout_t = (bf16_t*)(ws + WS_WOUT);
    bf16_t* Wq_t = (bf16_t*)(ws + WS_WQ); bf16_t* Wkv_t = (bf16_t*)(ws + WS_WKV); bf16_t* Wo_t = (bf16_t*)(ws + WS_WO); bf16_t* Wgu_t = (bf16_t*)(ws + WS_WGU); bf16_t* Wdn_t = (bf16_t*)(ws + WS_WDN);
    bf16_t* MEMN = (bf16_t*)(ws + WS_MEMN); bf16_t* KVM = (bf16_t*)(ws + WS_KVM); unsigned* BMK = (unsigned*)(ws + WS_BM);
    bf16_t* H = (bf16_t*)(ws + WS_H); bf16_t* ATT = H;
    bf16_t* U = (bf16_t*)(ws + WS_U); bf16_t* Q = (bf16_t*)(ws + WS_Q); bf16_t* KV = (bf16_t*)(ws + WS_KV); bf16_t* QI = (bf16_t*)(ws + WS_QI); bf16_t* KI = (bf16_t*)(ws + WS_KI);
    bf16_t* GP = (bf16_t*)(ws + WS_GP); bf16_t* GA = (bf16_t*)(ws + WS_GA); bf16_t* PL = (bf16_t*)(ws + WS_PL); bf16_t* AB = (bf16_t*)(ws + WS_AB);
    bf16_t* MG = (bf16_t*)(ws + WS_MG); bf16_t* MIX = (bf16_t*)(ws + WS_MIX); bf16_t* QM = (bf16_t*)(ws + WS_QM); bf16_t* OM = (bf16_t*)(ws + WS_OM); bf16_t* ACT = (bf16_t*)(ws + WS_ACT);

    const int gw = bid * NWAVES + wave, NGW = G * NWAVES;

    {
        float* scr = (float*)(lds + wave * 16384);
        constexpr int I_A = 16 * 67, I_B = 16 * 64, I_PA = 16 * 32, I_OUT = 16 * 32, I_Q = 16 * 16, I_KV = 16 * 32, I_O = 8 * 32, I_GU = 16 * 176, I_DN = 44 * 32;
        constexpr int NITEMS = I_A + I_B + I_PA + I_OUT + I_Q + I_KV + I_O + I_GU + I_DN;
        for (int it = gw; it < NITEMS; it += NGW) {
            int r = it;
            if (r < I_A) { tr_item(w_in, IN_W, 0, 2116, 1024, Win_t, 0, scr, r / 67, r % 67, lane); continue; } r -= I_A;
            if (r < I_B) { tr_item(w_in, IN_W, 2116, 2048, 1024, Win_t, 2304, scr, r / 64, r % 64, lane); continue; } r -= I_B;
            if (r < I_PA) { tr_item(w_proj_attn, 1024, 0, 1024, 1024, Wpa_t, 0, scr, r / 32, r % 32, lane); continue; } r -= I_PA;
            if (r < I_OUT) { tr_item(w_out, 1024, 0, 1024, 1024, Wout_t, 0, scr, r / 32, r % 32, lane); continue; } r -= I_OUT;
            if (r < I_Q) { tr_item(w_q_mem, 512, 0, 512, 1024, Wq_t, 0, scr, r / 16, r % 16, lane); continue; } r -= I_Q;
            if (r < I_KV) { tr_item(w_kv_mem, 1024, 0, 1024, 1024, Wkv_t, 0, scr, r / 32, r % 32, lane); continue; } r -= I_KV;
            if (r < I_O) { tr_item(w_o_mem, 1024, 0, 1024, 512, Wo_t, 0, scr, r / 32, r % 32, lane); continue; } r -= I_O;
            if (r < I_GU) { const int kb = r / 176, nb = r % 176; const int n0 = 32 * nb, pn = n0 / 256, half = (n0 % 256) / 128, jj0 = n0 % 128;
                const int src = half * DFF + pn * 128 + jj0;
                tr_item(w_gate_up, 2 * DFF, src - n0, 1 << 30, 1024, Wgu_t, 0, scr, kb, nb, lane); continue; } r -= I_GU;
            tr_item(w_down, 1024, 0, 1024, DFF, Wdn_t, 0, scr, r / 32, r % 32, lane);
        }
        for (int i = bid * NTHR + tid; i < 160 * 1024 / 8; i += G * NTHR) *(u32x4*)(Win_t + (size_t)2144 * 1024 + (size_t)i * 8) = (u32x4){0u, 0u, 0u, 0u};
        for (int i = bid * NTHR + tid; i < 512 * 1024; i += G * NTHR) {
            const int k = i >> 10, n = i & 1023, gq = k >> 7;
            const float* pw = pool_w + (size_t)k * 128; float acc = 0.f;
            for (int d = 0; d < 128; ++d) acc += pw[d] * pool_scale[gq * 128 + d] * w_proj_pool[(size_t)(gq * 128 + d) * 1024 + n];
            Weff_t[(size_t)n * 512 + k] = f2bf(acc);
        }
        for (int m = gw; m < M + MMEM; m += NGW) {
            if (m < M) rms_row_to_bf16(x + (size_t)m * DM, g_mix_pre, H + (size_t)m * DM, lane);
            else rms_row_to_bf16(mem + (size_t)(m - M) * DM, g_mem_kv, MEMN + (size_t)(m - M) * DM, lane);
        }
    }
    xcd_barrier(bar);

    {
        { pg8::Gemm g{MEMN, Wkv_t, MMEM, 1024, 1024}; pg8::StaticOrder S; S.init(MMEM, 1024, G, bid); pg8::EpiBf E{KVM, 1024}; pg8::gemm_simple(g, S, E); }
        { pg8::Gemm g{H, Win_t, M, IN_PAD, 1024}; pg8::StaticOrder S; S.init(M, IN_PAD, G, bid); pg8::EpiP1 E{U, Q, KV, QI, KI, GP, GA}; pg8::gemm_simple(g, S, E); }
    }
    xcd_barrier(bar);

    {
        for (int i = bid * NTHR + tid; i < M * 64; i += G * NTHR) {
            const int tok = i >> 6, c8 = (i & 63) * 8, t = tok & (SEQ - 1), w = 2 << (c8 >> 7);
            const u32x4 cur = *(const u32x4*)(U + (size_t)tok * 512 + c8);
            float s[8], c[8]; c[0] = bflo(cur.x); c[1] = bfhi(cur.x); c[2] = bflo(cur.y); c[3] = bfhi(cur.y); c[4] = bflo(cur.z); c[5] = bfhi(cur.z); c[6] = bflo(cur.w); c[7] = bfhi(cur.w);
#pragma unroll
            for (int e = 0; e < 8; ++e) s[e] = c[e];
            const int cnt = (t + 1 < w) ? t + 1 : w;
            for (int j = 1; j < cnt; ++j) { const u32x4 p = *(const u32x4*)(U + (size_t)(tok - j) * 512 + c8);
                s[0] += bflo(p.x); s[1] += bfhi(p.x); s[2] += bflo(p.y); s[3] += bfhi(p.y); s[4] += bflo(p.z); s[5] += bfhi(p.z); s[6] += bflo(p.w); s[7] += bfhi(p.w); }
            const float inv = 1.f / (float)cnt; u32x4 o;
            o.x = cvtpk(s[0] * inv - c[0], s[1] * inv - c[1]); o.y = cvtpk(s[2] * inv - c[2], s[3] * inv - c[3]);
            o.z = cvtpk(s[4] * inv - c[4], s[5] * inv - c[5]); o.w = cvtpk(s[6] * inv - c[6], s[7] * inv - c[7]);
            *(u32x4*)(PL + (size_t)tok * 512 + c8) = o;
        }
        unsigned* sc = (unsigned*)lds;
        unsigned* hist = (unsigned*)(lds + 16384);
        float* qs = (float*)(lds + 16384 + 1024);
        float* wsv = (float*)(lds + 16384 + 2048);
        unsigned* sel = (unsigned*)(lds + 16384 + 2048 + 64);
        for (int tok = bid; tok < M; tok += G) {
            const int b = tok >> 12, t = tok & (SEQ - 1), n = t + 1;
            if (tid < 256) qs[tid] = bf2f(QI[(size_t)tok * 256 + tid]);
            if (tid < 4) wsv[tid] = bf2f(KI[(size_t)tok * 256 + 64 + tid]) * 0.5f;
            __syncthreads();
            for (int s = tid; s < n; s += NTHR) {
                asm volatile("" ::: "memory");
                const bf16_t* kr = KI + (size_t)(b * SEQ + s) * 256;
                float d0 = 0.f, d1 = 0.f, d2 = 0.f, d3 = 0.f;
#pragma unroll
                for (int j = 0; j < 8; ++j) { const u32x4 kw = *(const u32x4*)(kr + 8 * j);
                    const float kf[8] = {bflo(kw.x), bfhi(kw.x), bflo(kw.y), bfhi(kw.y), bflo(kw.z), bfhi(kw.z), bflo(kw.w), bfhi(kw.w)};
#pragma unroll
                    for (int e = 0; e < 8; ++e) { d0 += qs[8 * j + e] * kf[e]; d1 += qs[64 + 8 * j + e] * kf[e]; d2 += qs[128 + 8 * j + e] * kf[e]; d3 += qs[192 + 8 * j + e] * kf[e]; } }
                float score = wsv[0] * fmaxf(d0 * 0.125f, 0.f) + wsv[1] * fmaxf(d1 * 0.125f, 0.f) + wsv[2] * fmaxf(d2 * 0.125f, 0.f) + wsv[3] * fmaxf(d3 * 0.125f, 0.f);
                score += 0.0f;
                sc[s] = fkey(score);
            }
            __syncthreads();
            unsigned tau = 0u; int cutoff = n - 1;
            if (n > 256) {
                unsigned prefix = 0u; unsigned need = 256u; unsigned ceq = 0u;
                for (int p = 0; p < 4; ++p) {
                    const int shift = 24 - 8 * p;
                    if (tid < 256) hist[tid] = 0u;
                    __syncthreads();
                    for (int s = tid; s < n; s += NTHR) { const unsigned key = sc[s];
                        if (p == 0 || (key >> (shift + 8)) == (prefix >> (shift + 8))) atomicAdd(&hist[(key >> shift) & 255u], 1u); }
                    __syncthreads();
                    if (tid == 0) { unsigned nd = need; int d = 255; for (; d > 0; --d) { const unsigned c = hist[d]; if (nd <= c) break; nd -= c; } sel[0] = (unsigned)d; sel[1] = nd; sel[3] = hist[d]; }
                    __syncthreads();
                    prefix |= sel[0] << shift; need = sel[1]; ceq = sel[3];
                    __syncthreads();
                }
                tau = prefix;
                if (need < ceq) {
                    if (tid == 0) { unsigned c = 0; int s = 0; for (; s < n; ++s) { if (sc[s] == tau) { if (++c == need) break; } } sel[2] = (unsigned)s; }
                    __syncthreads();
                    cutoff = (int)sel[2];
                }
            }
#pragma unroll
            for (int i = 0; i < 8; ++i) {
                const int s = i * NTHR + tid; bool f = false;
                if (s < n) { const unsigned key = sc[s]; f = (key > tau) || (key == tau && s <= cutoff); }
                const unsigned long long bm = __ballot(f);
                if (lane == 0) { *(u32x2*)(BMK + (size_t)tok * 128 + (i * NTHR + wave * 64) / 32) = (u32x2){(unsigned)bm, (unsigned)(bm >> 32)}; }
            }
            __syncthreads();
        }
    }
    xcd_barrier(bar);

    {
        { pg8::Gemm g{PL, Weff_t, M, 1024, 512}; pg8::StaticOrder S; S.init(M, 1024, G, bid); pg8::EpiBf E{AB, 1024}; pg8::gemm_simple(g, S, E); }
        int* list = (int*)lds;
        unsigned* wbits = (unsigned*)(lds + 1024);
        unsigned* wcnt = (unsigned*)(lds + 1536);
        int* lut = (int*)(lds + 2048);
        float* qs = (float*)(lds + 4096);
        float* ps = (float*)(lds + 8192);
        int* nselp = (int*)(lds + 16384);
        if (tid < 128) { int bk = tid; if (tid >= 16) { const float nf = (float)tid; int lg = 16 + (int)(logf(nf / 16.f) / logf(8.f) * 16.f); bk = lg < 31 ? lg : 31; } lut[tid] = bk; }
        __syncthreads();
        for (int tok = bid; tok < M; tok += G) {
            const int b = tok >> 12, t = tok & (SEQ - 1);
            if (tid < 128) { const unsigned w = BMK[(size_t)tok * 128 + tid]; wbits[tid] = w; wcnt[tid] = __popc(w); }
            for (int i = tid; i < 1024; i += NTHR) qs[i] = bf2f(Q[(size_t)tok * 1024 + i]);
            __syncthreads();
            if (tid < 128) { int off = 0; for (int j = 0; j < tid; ++j) off += wcnt[j]; unsigned w = wbits[tid]; int pos = off;
                while (w) { const int bit = __ffs(w) - 1; list[pos++] = tid * 32 + bit; w &= w - 1; }
                if (tid == 127) nselp[0] = pos; }
            __syncthreads();
            const int nsel = nselp[0]; const int h = wave;
            float lg[4]; float mx = -INFINITY;
#pragma unroll
            for (int jj = 0; jj < 4; ++jj) { const int j = lane + 64 * jj; lg[jj] = -INFINITY; asm volatile("" ::: "memory");
                if (j < nsel) { const int s = list[j]; const bf16_t* kr = KV + (size_t)(b * SEQ + s) * 256; float d = 0.f;
#pragma unroll
                    for (int q8 = 0; q8 < 16; ++q8) { const u32x4 kw = *(const u32x4*)(kr + 8 * q8); const float* qq = qs + h * 128 + 8 * q8;
                        d += qq[0] * bflo(kw.x) + qq[1] * bfhi(kw.x) + qq[2] * bflo(kw.y) + qq[3] * bfhi(kw.y) + qq[4] * bflo(kw.z) + qq[5] * bfhi(kw.z) + qq[6] * bflo(kw.w) + qq[7] * bfhi(kw.w); }
                    const int dist = t - s; const int bk = dist < 128 ? lut[dist] : 31;
                    lg[jj] = d * 0.08838834764831845f + rel_bias[bk * 8 + h]; }
                mx = fmaxf(mx, lg[jj]); }
            mx = wave_max(mx); float sum = 0.f;
#pragma unroll
            for (int jj = 0; jj < 4; ++jj) { lg[jj] = (lg[jj] == -INFINITY) ? 0.f : __expf(lg[jj] - mx); sum += lg[jj]; }
            sum = wave_sum(sum); const float inv = 1.f / sum;
#pragma unroll
            for (int jj = 0; jj < 4; ++jj) ps[h * 256 + lane + 64 * jj] = lg[jj] * inv;
            __syncthreads();
            float a0 = 0.f, a1 = 0.f;
            for (int j = 0; j < nsel; ++j) { const int s = list[j]; const unsigned vw = *(const unsigned*)(KV + (size_t)(b * SEQ + s) * 256 + 128 + 2 * lane); const float p = ps[h * 256 + j];
                a0 += p * bflo(vw); a1 += p * bfhi(vw); }
            *(unsigned*)(ATT + (size_t)tok * 1024 + h * 128 + 2 * lane) = cvtpk(a0, a1);
            __syncthreads();
        }
    }
    xcd_barrier(bar);

    { pg8::Gemm g{ATT, Wpa_t, M, 1024, 1024}; pg8::StaticOrder S; S.init(M, 1024, G, bid); pg8::EpiMerge E{AB, GP, GA, MG}; pg8::gemm_simple(g, S, E); }
    xcd_barrier(bar);
    { pg8::Gemm g{MG, Wout_t, M, 1024, 1024}; pg8::StaticOrder S; S.init(M, 1024, G, bid); pg8::EpiBf E{MIX, 1024}; pg8::gemm_simple(g, S, E); }
    xcd_barrier(bar);
    for (int m = gw; m < M; m += NGW) res_norm_row(x + (size_t)m * DM, MIX + (size_t)m * DM, g_mix_post, out + (size_t)m * DM, g_mem_pre, H + (size_t)m * DM, lane);
    xcd_barrier(bar);
    { pg8::Gemm g{H, Wq_t, M, 512, 1024}; pg8::StaticOrder S; S.init(M, 512, G, bid); pg8::EpiBf E{QM, 512}; pg8::gemm_simple(g, S, E); }
    xcd_barrier(bar);
    {
        float* qs = (float*)lds;
        float* ps = (float*)(lds + 4096);
        for (int tp = bid; tp < M / 2; tp += G) {
            for (int i = tid; i < 1024; i += NTHR) qs[i] = bf2f(QM[(size_t)tp * 1024 + i]);
            __syncthreads();
            const int tok = tp * 2 + (wave >> 2), h = wave & 3, b = tok >> 12;
            const float* qq = qs + (wave >> 2) * 512 + h * 128;
            float lg[4]; float mx = -INFINITY;
#pragma unroll
            for (int jj = 0; jj < 4; ++jj) { const int j = lane + 64 * jj; asm volatile("" ::: "memory"); const bf16_t* kr = KVM + (size_t)(b * NMEM + j) * 1024 + h * 128; float d = 0.f;
#pragma unroll
                for (int q8 = 0; q8 < 16; ++q8) { const u32x4 kw = *(const u32x4*)(kr + 8 * q8); const float* q = qq + 8 * q8;
                    d += q[0] * bflo(kw.x) + q[1] * bfhi(kw.x) + q[2] * bflo(kw.y) + q[3] * bfhi(kw.y) + q[4] * bflo(kw.z) + q[5] * bfhi(kw.z) + q[6] * bflo(kw.w) + q[7] * bfhi(kw.w); }
                lg[jj] = d * 0.08838834764831845f; mx = fmaxf(mx, lg[jj]); }
            mx = wave_max(mx); float sum = 0.f;
#pragma unroll
            for (int jj = 0; jj < 4; ++jj) { lg[jj] = __expf(lg[jj] - mx); sum += lg[jj]; }
            sum = wave_sum(sum); const float inv = 1.f / sum;
#pragma unroll
            for (int jj = 0; jj < 4; ++jj) ps[wave * 256 + lane + 64 * jj] = lg[jj] * inv;
            __syncthreads();
            float a0 = 0.f, a1 = 0.f;
            for (int j = 0; j < NMEM; ++j) { const unsigned vw = *(const unsigned*)(KVM + (size_t)(b * NMEM + j) * 1024 + 512 + h * 128 + 2 * lane); const float p = ps[wave * 256 + j];
                a0 += p * bflo(vw); a1 += p * bfhi(vw); }
            *(unsigned*)(OM + (size_t)tok * 512 + h * 128 + 2 * lane) = cvtpk(a0, a1);
            __syncthreads();
        }
    }
    xcd_barrier(bar);
    { pg8::Gemm g{OM, Wo_t, M, 1024, 512}; pg8::StaticOrder S; S.init(M, 1024, G, bid); pg8::EpiBf E{MIX, 1024}; pg8::gemm_simple(g, S, E); }
    xcd_barrier(bar);
    for (int m = gw; m < M; m += NGW) res_norm_row(out + (size_t)m * DM, MIX + (size_t)m * DM, g_mem_post, out + (size_t)m * DM, g_ffn_pre, H + (size_t)m * DM, lane);
    xcd_barrier(bar);
    { pg8::Gemm g{H, Wgu_t, M, 2 * DFF, 1024}; pg8::StaticOrder S; S.init(M, 2 * DFF, G, bid); pg8::EpiSwiglu E{ACT}; pg8::gemm_simple(g, S, E); }
    xcd_barrier(bar);
    { pg8::Gemm g{ACT, Wdn_t, M, 1024, DFF}; pg8::StaticOrder S; S.init(M, 1024, G, bid); pg8::EpiBf E{MIX, 1024}; pg8::gemm_simple(g, S, E); }
    xcd_barrier(bar);
    for (int m = gw; m < M; m += NGW) res_norm_row(out + (size_t)m * DM, MIX + (size_t)m * DM, g_ffn_post, out + (size_t)m * DM, nullptr, nullptr, lane);
}

extern "C" void kernel_launch(void* const* d_in, const int* in_sizes, int n_in, void* d_out, int out_size, void* d_ws, size_t ws_size, hipStream_t stream) {
    static int grid = 0;
    if (grid == 0) {
        if (n_in != 21 || in_sizes[0] != M * DM || out_size != M * DM || ws_size < WS_END) { fprintf(stderr, "kernel_launch: unexpected shapes (n_in %d, in0 %d, out %d, ws %zu)\n", n_in, n_in > 0 ? in_sizes[0] : -1, out_size, ws_size); grid = -1; return; }
        int dev = 0, cus = 0, per_cu = 0;
        if (hipGetDevice(&dev) != hipSuccess || hipDeviceGetAttribute(&cus, hipDeviceAttributeMultiprocessorCount, dev) != hipSuccess) { grid = -1; return; }
        if (hipFuncSetAttribute((const void*)fwd_kernel, hipFuncAttributeMaxDynamicSharedMemorySize, LDS_BYTES) != hipSuccess) { fprintf(stderr, "kernel_launch: hipFuncSetAttribute failed\n"); grid = -1; return; }
        if (hipOccupancyMaxActiveBlocksPerMultiprocessor(&per_cu, (const void*)fwd_kernel, NTHR, LDS_BYTES) != hipSuccess || per_cu < 1) { fprintf(stderr, "kernel_launch: occupancy query says %d blocks per CU\n", per_cu); }
        (void)hipGetLastError();
        grid = cus;
    }
    if (grid < 0) return;
    (void)hipMemsetAsync((char*)d_ws + WS_CTL, 0, CTL_ZERO_BYTES, stream);
    Args a{};
    for (int i = 0; i < 21; ++i) a.in[i] = (const float*)d_in[i];
    a.out = (float*)d_out; a.ws = (unsigned char*)d_ws;
    hipLaunchKernelGGL(fwd_kernel, dim3(grid), dim3(NTHR), LDS_BYTES, stream, a);
}
```

```cpp
#include <hip/hip_runtime.h>
#include <cstdio>
#include <cstdint>

#define LAS __attribute__((address_space(3)))
typedef unsigned short bf16_t;
typedef short bf16x8 __attribute__((ext_vector_type(8)));
typedef float f32x4 __attribute__((ext_vector_type(4)));
typedef float f32x2 __attribute__((ext_vector_type(2)));
typedef unsigned u32x4 __attribute__((ext_vector_type(4)));
typedef unsigned u32x2 __attribute__((ext_vector_type(2)));
typedef __bf16 bf16x2_t __attribute__((ext_vector_type(2)));

constexpr int NWAVES = 8, NTHR = 512;
constexpr int BATCH = 8, SEQ = 4096, DM = 1024, M = BATCH * SEQ;
constexpr int NMEM = 256, MMEM = BATCH * NMEM;
constexpr int DFF = 2816;
constexpr int IN_W = 4164, IN_PAD = 4352;
constexpr float EPS = 1e-6f;

constexpr size_t MiB = 1u << 20;
constexpr size_t WS_CTL = 0, CTL_ZERO_BYTES = 64 * 1024;
constexpr size_t WS_WIN = 1 * MiB;
constexpr size_t WS_WEFF = 10 * MiB;
constexpr size_t WS_WPA = 11 * MiB;
constexpr size_t WS_WOUT = 13 * MiB;
constexpr size_t WS_WQ = 15 * MiB;
constexpr size_t WS_WKV = 16 * MiB;
constexpr size_t WS_WO = 18 * MiB;
constexpr size_t WS_WGU = 19 * MiB;
constexpr size_t WS_WDN = 30 * MiB;
constexpr size_t WS_MEMN = 36 * MiB;
constexpr size_t WS_KVM = 40 * MiB;
constexpr size_t WS_BM = 44 * MiB;
constexpr size_t WS_H = 64 * MiB;
constexpr size_t WS_U = 128 * MiB;
constexpr size_t WS_Q = 160 * MiB;
constexpr size_t WS_KV = 224 * MiB;
constexpr size_t WS_QI = 240 * MiB;
constexpr size_t WS_KI = 256 * MiB;
constexpr size_t WS_GP = 272 * MiB;
constexpr size_t WS_GA = 336 * MiB;
constexpr size_t WS_PL = 400 * MiB;
constexpr size_t WS_AB = 432 * MiB;
constexpr size_t WS_MG = 128 * MiB;
constexpr size_t WS_MIX = 192 * MiB;
constexpr size_t WS_QM = 256 * MiB;
constexpr size_t WS_OM = 288 * MiB;
constexpr size_t WS_ACT = 320 * MiB;
constexpr size_t WS_END = 496 * MiB;

constexpr int CW_BAR = 1024;

constexpr int RING_BYTES = 131072;
constexpr int LDSCTL_OFF = RING_BYTES, MISC_OFF = LDSCTL_OFF + 320;
constexpr int LDS_BYTES = 147456;

__device__ __forceinline__ unsigned cvtpk(float lo, float hi) { f32x2 v = {lo, hi}; bf16x2_t b = __builtin_convertvector(v, bf16x2_t); return __builtin_bit_cast(unsigned, b); }
__device__ __forceinline__ bf16_t f2bf(float f) { return (bf16_t)(cvtpk(f, 0.f) & 0xffffu); }
__device__ __forceinline__ float bf2f(bf16_t b) { return __uint_as_float((unsigned)b << 16); }
__device__ __forceinline__ float bflo(unsigned w) { return __uint_as_float(w << 16); }
__device__ __forceinline__ float bfhi(unsigned w) { return __uint_as_float(w & 0xffff0000u); }
__device__ __forceinline__ float wave_sum(float v) {
#pragma unroll
    for (int o = 1; o < 64; o <<= 1) v += __shfl_xor(v, o);
    return v;
}
__device__ __forceinline__ float wave_max(float v) {
#pragma unroll
    for (int o = 1; o < 64; o <<= 1) v = fmaxf(v, __shfl_xor(v, o));
    return v;
}
__device__ __forceinline__ unsigned fkey(float f) { const unsigned b = __float_as_uint(f); return (b & 0x80000000u) ? ~b : (b | 0x80000000u); }
__device__ __forceinline__ float sigmoidf_(float x) { return 1.f / (1.f + __expf(-x)); }

#define XB_TMO      128
#define XB_XCNT(j)  (256  + 64 * (j))
#define XB_XSUB(j)  (1280 + 64 * (j))
#define XB_XGEN(j)  (2304 + 64 * (j))
#define XB_TOP      3328
#define XB_TOPGEN   3392
#define XCD_BAR_WORDS 3456
#define XB_SPIN_CAP (1u << 22)

__device__ __forceinline__ unsigned xb_ld(unsigned* p)              { return __hip_atomic_load(p, __ATOMIC_RELAXED, __HIP_MEMORY_SCOPE_AGENT); }
__device__ __forceinline__ unsigned xb_add(unsigned* p, unsigned v) { return __hip_atomic_fetch_add(p, v, __ATOMIC_RELAXED, __HIP_MEMORY_SCOPE_AGENT); }
__device__ __forceinline__ unsigned xb_xcc_id() { return (unsigned)__builtin_amdgcn_s_getreg((3 << 11) | 20) & 0xFu; }
#define XB_SPIN(cond, bar) do { unsigned _sp = 0; while (cond) { __builtin_amdgcn_s_sleep(1); \
    if ((++_sp & 255u) == 0u) { if (xb_ld(&(bar)[XB_TMO])) break; if (_sp > XB_SPIN_CAP) { atomicAdd(&(bar)[XB_TMO], 1u); break; } } } } while (0)

struct XcdBarrier { unsigned* bar; unsigned x; volatile LAS unsigned* st; };

__device__ __forceinline__ XcdBarrier xcd_barrier_post(unsigned* bar, volatile LAS unsigned* st) {
    XcdBarrier b; b.bar = bar; b.x = xb_xcc_id(); b.st = st;
    if (threadIdx.x == 0) (void)xb_add(&bar[XB_XCNT(b.x)], 1u);
    return b;
}
__device__ __forceinline__ void xcd_barrier_complete(unsigned* bar, unsigned x, unsigned& nloc, unsigned& nx) {
    const unsigned G = gridDim.x * gridDim.y * gridDim.z;
    unsigned sum, cnt, mine, sp = 0u;
    for (;;) {
        sum = 0u; cnt = 0u; mine = 0u;
#pragma unroll
        for (unsigned j = 0; j < 16; ++j) { const unsigned c = xb_ld(&bar[XB_XCNT(j)]); sum += c; cnt += (c > 0u) ? 1u : 0u; mine = (j == x) ? c : mine; }
        if (sum == G) break;
        __builtin_amdgcn_s_sleep(1);
        if ((++sp & 255u) == 0u) { if (xb_ld(&bar[XB_TMO])) break; if (sp > XB_SPIN_CAP) { atomicAdd(&bar[XB_TMO], 1u); break; } }
    }
    nloc = mine > 0u ? mine : 1u; nx = cnt > 0u ? cnt : 1u;
}
__device__ __forceinline__ void xcd_barrier(const XcdBarrier& b) {
    asm volatile("s_waitcnt vmcnt(0)" ::: "memory");
    __syncthreads();
    if (threadIdx.x == 0) {
        unsigned* bar = b.bar;
        __builtin_amdgcn_s_waitcnt(0);
        unsigned nloc = b.st[0], nx = b.st[1];
        if (nloc == 0u) { xcd_barrier_complete(bar, b.x, nloc, nx); b.st[0] = nloc; b.st[1] = nx; }
        const unsigned old = xb_add(&bar[XB_XSUB(b.x)], 1u);
        const unsigned gen = old / nloc;
        if (old + 1u == (gen + 1u) * nloc) {
            __builtin_amdgcn_fence(__ATOMIC_RELEASE, "agent");
            asm volatile("s_waitcnt vmcnt(0)" ::: "memory");
            const unsigned og = xb_add(&bar[XB_TOP], 1u);
            const unsigned tg = og / nx;
            if (og + 1u == (tg + 1u) * nx) xb_add(&bar[XB_TOPGEN], 1u);
            else XB_SPIN(xb_ld(&bar[XB_TOPGEN]) == tg, bar);
            __builtin_amdgcn_fence(__ATOMIC_ACQUIRE, "agent");
            xb_add(&bar[XB_XGEN(b.x)], 1u);
            asm volatile("s_waitcnt vmcnt(0)" ::: "memory");
        } else {
            XB_SPIN(xb_ld(&bar[XB_XGEN(b.x)]) == gen, bar);
            __builtin_amdgcn_fence(__ATOMIC_ACQUIRE, "agent");
            asm volatile("s_waitcnt vmcnt(0)" ::: "memory");
        }
    }
    __syncthreads();
}

namespace pg8 {
constexpr int BM = 256, HALF = 128, NXCD = 8, WGM = 8;
struct Unit { int pm, pn; };
struct Gemm { const bf16_t* A; const bf16_t* Bt; int M, N, K; };
struct StaticOrder {
    int nM, nN, nwg, G, c;
    __device__ void init(int M_, int N_, int G_, int c_) { nM = M_ / BM; nN = N_ / BM; nwg = nM * nN; G = G_; c = c_; }
    __device__ bool next(int i, Unit& u) const {
        const long L = (long)i * G + c; if (L >= nwg) return false;
        int wgid = (int)L; { const int q = nwg / NXCD, r = nwg % NXCD, xcd = wgid % NXCD, off = wgid / NXCD; wgid = (xcd < r ? xcd * (q + 1) : r * (q + 1) + (xcd - r) * q) + off; }
        const int nig = WGM * nN, gid = wgid / nig, fm = gid * WGM, gsz = (nM - fm) < WGM ? (nM - fm) : WGM;
        u.pm = fm + ((wgid % nig) % gsz); u.pn = (wgid % nig) / gsz; return true;
    }
    __device__ __forceinline__ void a_ready(const Unit&) const {}
    __device__ __forceinline__ void done(const Unit&) const {}
};
template <class Epi>
__device__ __forceinline__ void gemm_simple(const Gemm g, const StaticOrder& S, const Epi& E) {
    const int tid = threadIdx.x, wid = __builtin_amdgcn_readfirstlane(tid >> 6), lane = tid & 63, wr = wid >> 2, wc = wid & 3, fr = lane & 15, fq = lane >> 4;
    const int K = g.K;
    Unit u;
    for (int i = 0; S.next(i, u); ++i) {
        f32x4 acc[2][2][4][2];
#pragma unroll
        for (int a = 0; a < 2; ++a)
#pragma unroll
            for (int b = 0; b < 2; ++b)
#pragma unroll
                for (int m = 0; m < 4; ++m)
#pragma unroll
                    for (int n = 0; n < 2; ++n) acc[a][b][m][n] = (f32x4){0.f, 0.f, 0.f, 0.f};
        const bf16_t* Ab = g.A + (size_t)(u.pm * BM + wr * 64 + fr) * K + fq * 8;
        const bf16_t* Bb = g.Bt + (size_t)(u.pn * BM + wc * 32 + fr) * K + fq * 8;
        for (int kk = 0; kk < K; kk += 32) {
            bf16x8 Bf[2][2];
#pragma unroll
            for (int b = 0; b < 2; ++b)
#pragma unroll
                for (int n = 0; n < 2; ++n) Bf[b][n] = *(const bf16x8*)(Bb + (size_t)(b * HALF + n * 16) * K + kk);
#pragma unroll
            for (int a = 0; a < 2; ++a) {
                bf16x8 At[4];
#pragma unroll
                for (int m = 0; m < 4; ++m) At[m] = *(const bf16x8*)(Ab + (size_t)(a * HALF + m * 16) * K + kk);
#pragma unroll
                for (int b = 0; b < 2; ++b)
#pragma unroll
                    for (int m = 0; m < 4; ++m)
#pragma unroll
                        for (int n = 0; n < 2; ++n) acc[a][b][m][n] = __builtin_amdgcn_mfma_f32_16x16x32_bf16(Bf[b][n], At[m], acc[a][b][m][n], 0, 0, 0);
            }
        }
        E(acc, u, wr, wc, fr, fq);
    }
}
#define PG8_LAS __attribute__((address_space(3)))
constexpr int BK = 64, HTB = HALF * BK * 2, STAGE_BYTES = 8 * HTB;
__host__ __device__ __forceinline__ int lds_byte(int r, int c) { const int st = (r >> 4) * 2 + (c >> 5), rr = r & 15, cc = c & 31, ob = rr * 64 + cc * 2; return st * 1024 + (ob ^ (((ob >> 9) & 1) << 5)); }
__host__ __device__ __forceinline__ void stage_rc(int b, int& R, int& C) { const int st = b / 1024, sb = b % 1024, swz = sb ^ (((sb >> 9) & 1) << 5); R = (st >> 1) * 16 + swz / 64; C = (st & 1) * 32 + (swz % 64) / 2; }
__host__ __device__ __forceinline__ int perm32(int rho) { const int n = rho >> 4, i = rho & 15; return 8 * (i >> 2) + 4 * n + (i & 3); }
template <class Epi, class Sched, bool ALIGN_EPI = false, bool SP2 = false>
__device__ __forceinline__ void gemm_phase(PG8_LAS unsigned char* lds, const Gemm g, const Sched& S, const Epi& E) {
    const int tid = threadIdx.x, wid = __builtin_amdgcn_readfirstlane(tid >> 6), lane = tid & 63, wr = wid >> 2, wc = wid & 3, fr = lane & 15, fq = lane >> 4;
    const int K = g.K, nt = K / BK;
    unsigned voffA[2], voffB[2];
#pragma unroll
    for (int i = 0; i < 2; ++i) { int R, C; stage_rc(tid * 16 + i * 8192, R, C); const int Rb = Epi::PERM ? ((R & ~31) + perm32(R & 31)) : R;
        voffA[i] = (unsigned)(R * K + C) * 2u; voffB[i] = (unsigned)(Rb * K + C) * 2u; }
    const size_t kstep = (size_t)(BK * 2);
    const size_t hstep = (size_t)HALF * K * 2;
    const size_t tstep = 2 * hstep;
    const unsigned ldsw = (unsigned)wid * 1024u;
    const int aoff = lds_byte(wr * 64 + fr, fq * 8), boff = lds_byte(wc * 32 + fr, fq * 8);
#define PG8_SA(b, h) (((b) * 2 + (h)) * HTB)
#define PG8_SB(b, h) ((4 + (b) * 2 + (h)) * HTB)
#define PG8_STAGE(bufoff, gbase, voff) do { _Pragma("unroll") for (int _i = 0; _i < 2; ++_i) \
        __builtin_amdgcn_global_load_lds((const unsigned*)((const char*)(gbase) + (voff)[_i]), (PG8_LAS unsigned*)(lds + (bufoff) + ldsw + _i * 8192), 16, 0, 0); } while (0)
#define PG8_LDA(dst, b, h) do { _Pragma("unroll") for (int m = 0; m < 4; ++m) _Pragma("unroll") for (int k = 0; k < 2; ++k) dst[m][k] = *(const PG8_LAS bf16x8*)(lds + PG8_SA(b, h) + aoff + m * 2048 + k * 1024); } while (0)
#define PG8_LDB(dst, b, h) do { _Pragma("unroll") for (int n = 0; n < 2; ++n) _Pragma("unroll") for (int k = 0; k < 2; ++k) dst[n][k] = *(const PG8_LAS bf16x8*)(lds + PG8_SB(b, h) + boff + n * 2048 + k * 1024); } while (0)
#define PG8_MMA(ai, bj, At, Bt) do { __builtin_amdgcn_s_setprio(1); _Pragma("unroll") for (int m = 0; m < 4; ++m) _Pragma("unroll") for (int n = 0; n < 2; ++n) _Pragma("unroll") for (int k = 0; k < 2; ++k) \
        acc[ai][bj][m][n] = __builtin_amdgcn_mfma_f32_16x16x32_bf16(Bt[n][k], At[m][k], acc[ai][bj][m][n], 0, 0, 0); __builtin_amdgcn_s_setprio(0); } while (0)
#define PG8_WAIT_V(n) asm volatile("s_waitcnt vmcnt(" #n ")" ::: "memory")
#define PG8_WAIT_L(n) asm volatile("s_waitcnt lgkmcnt(" #n ")" ::: "memory")
#define PG8_BAR __builtin_amdgcn_s_barrier()
#define PG8_SCHED __builtin_amdgcn_sched_barrier(0)
    Unit cur, nxt; int ui = 0;
    if (!S.next(0, cur)) return;
    f32x4 acc[2][2][4][2];
#pragma unroll
    for (int a = 0; a < 2; ++a)
#pragma unroll
        for (int b = 0; b < 2; ++b)
#pragma unroll
            for (int m = 0; m < 4; ++m)
#pragma unroll
                for (int n = 0; n < 2; ++n) acc[a][b][m][n] = (f32x4){0.f, 0.f, 0.f, 0.f};
    bf16x8 At[4][2], B0[2][2], B1[2][2];
    const char* cA = (const char*)g.A + (size_t)cur.pm * tstep; const char* cB = (const char*)g.Bt + (size_t)cur.pn * tstep;
    S.a_ready(cur);
    if constexpr (SP2) {
        PG8_STAGE(PG8_SB(0, 0), cB, voffB); PG8_STAGE(PG8_SB(0, 1), cB + hstep, voffB); PG8_STAGE(PG8_SA(0, 0), cA, voffA); PG8_STAGE(PG8_SA(0, 1), cA + hstep, voffA);
        if (wr == 1) PG8_BAR;
        PG8_WAIT_V(2); PG8_BAR;
        PG8_STAGE(PG8_SB(1, 0), cB + kstep, voffB); PG8_STAGE(PG8_SA(1, 0), cA + kstep, voffA); PG8_STAGE(PG8_SB(1, 1), cB + hstep + kstep, voffB);
        PG8_WAIT_V(6); PG8_BAR;
    } else {
        PG8_STAGE(PG8_SB(0, 0), cB, voffB); PG8_STAGE(PG8_SA(0, 0), cA, voffA); PG8_STAGE(PG8_SB(0, 1), cB + hstep, voffB); PG8_STAGE(PG8_SA(0, 1), cA + hstep, voffA);
        if (wr == 1) PG8_BAR;
        PG8_WAIT_V(4); PG8_BAR;
        PG8_STAGE(PG8_SB(1, 0), cB + kstep, voffB); PG8_STAGE(PG8_SA(1, 0), cA + kstep, voffA); PG8_STAGE(PG8_SB(1, 1), cB + hstep + kstep, voffB);
        PG8_WAIT_V(6); PG8_BAR;
    }
    for (;;) {
        const bool has_next = S.next(ui + 1, nxt);
        const char* nA = has_next ? (const char*)g.A + (size_t)nxt.pm * tstep : cA; const char* nB = has_next ? (const char*)g.Bt + (size_t)nxt.pn * tstep : cB;
        for (int t = 0; t < nt; t += 2) {
            const bool last = (t == nt - 2);
            const char* a1 = cA + (size_t)(t + 1) * kstep;
            const char* a2 = last ? nA : cA + (size_t)(t + 2) * kstep; const char* b2 = last ? nB : cB + (size_t)(t + 2) * kstep;
            const char* a3 = a2 + kstep; const char* b3 = b2 + kstep;
            if (last && has_next) S.a_ready(nxt);
            if constexpr (SP2) {
            PG8_LDB(B0, 0, 0); PG8_LDB(B1, 0, 1); PG8_SCHED; PG8_LDA(At, 0, 0); PG8_STAGE(PG8_SA(1, 1), a1 + hstep, voffA);
            PG8_WAIT_V(8); PG8_WAIT_L(0); PG8_BAR; PG8_MMA(0, 0, At, B0); PG8_MMA(0, 1, At, B1); PG8_BAR; PG8_SCHED;
            PG8_LDA(At, 0, 1); PG8_STAGE(PG8_SB(0, 0), b2, voffB); PG8_STAGE(PG8_SB(0, 1), b2 + hstep, voffB); PG8_STAGE(PG8_SA(0, 0), a2, voffA);
            PG8_WAIT_V(8); PG8_WAIT_L(0); PG8_BAR; PG8_MMA(1, 0, At, B0); PG8_MMA(1, 1, At, B1); PG8_BAR; PG8_SCHED;
            PG8_LDB(B0, 1, 0); PG8_LDB(B1, 1, 1); PG8_SCHED; PG8_LDA(At, 1, 0); PG8_STAGE(PG8_SA(0, 1), a2 + hstep, voffA);
            PG8_WAIT_V(8); PG8_WAIT_L(0); PG8_BAR; PG8_MMA(0, 0, At, B0); PG8_MMA(0, 1, At, B1); PG8_BAR; PG8_SCHED;
            PG8_LDA(At, 1, 1); PG8_STAGE(PG8_SB(1, 0), b3, voffB); PG8_STAGE(PG8_SB(1, 1), b3 + hstep, voffB); PG8_STAGE(PG8_SA(1, 0), a3, voffA);
            PG8_WAIT_V(8); PG8_WAIT_L(0); PG8_BAR; PG8_MMA(1, 0, At, B0); PG8_MMA(1, 1, At, B1); PG8_BAR; PG8_SCHED;
            } else {
            PG8_LDB(B0, 0, 0); PG8_SCHED; PG8_LDA(At, 0, 0); PG8_STAGE(PG8_SA(1, 1), a1 + hstep, voffA);
            PG8_WAIT_L(8); PG8_BAR; PG8_WAIT_L(0); PG8_MMA(0, 0, At, B0); PG8_BAR; PG8_SCHED;
            PG8_LDB(B1, 0, 1); PG8_STAGE(PG8_SB(0, 0), b2, voffB);
            PG8_BAR; PG8_WAIT_L(0); PG8_MMA(0, 1, At, B1); PG8_BAR;
            PG8_LDA(At, 0, 1); PG8_STAGE(PG8_SA(0, 0), a2, voffA);
            PG8_BAR; PG8_WAIT_L(0); PG8_MMA(1, 0, At, B0); PG8_BAR; PG8_SCHED;
            PG8_STAGE(PG8_SB(0, 1), b2 + hstep, voffB);
            PG8_WAIT_V(6); PG8_BAR; PG8_MMA(1, 1, At, B1); PG8_BAR;
            PG8_LDB(B0, 1, 0); PG8_SCHED; PG8_LDA(At, 1, 0); PG8_STAGE(PG8_SA(0, 1), a2 + hstep, voffA);
            PG8_WAIT_L(8); PG8_BAR; PG8_WAIT_L(0); PG8_MMA(0, 0, At, B0); PG8_BAR; PG8_SCHED;
            PG8_LDB(B1, 1, 1); PG8_STAGE(PG8_SB(1, 0), b3, voffB);
            PG8_BAR; PG8_WAIT_L(0); PG8_MMA(0, 1, At, B1); PG8_BAR;
            PG8_LDA(At, 1, 1); PG8_STAGE(PG8_SA(1, 0), a3, voffA);
            PG8_BAR; PG8_WAIT_L(0); PG8_MMA(1, 0, At, B0); PG8_BAR; PG8_SCHED;
            PG8_STAGE(PG8_SB(1, 1), b3 + hstep, voffB);
            PG8_WAIT_V(6); PG8_BAR; PG8_MMA(1, 1, At, B1); PG8_BAR;
            }
        }
        if constexpr (ALIGN_EPI) { if (wr == 0) PG8_BAR; }
        if constexpr (!Epi::AFTER_DRAIN) { E(acc, cur, wr, wc, fr, fq); S.done(cur); }
        if (!has_next) break;
#pragma unroll
        for (int a = 0; a < 2; ++a)
#pragma unroll
            for (int b = 0; b < 2; ++b)
#pragma unroll
                for (int m = 0; m < 4; ++m)
#pragma unroll
                    for (int n = 0; n < 2; ++n) acc[a][b][m][n] = (f32x4){0.f, 0.f, 0.f, 0.f};
        cur = nxt; cA = nA; cB = nB; ++ui;
        if constexpr (ALIGN_EPI) { if (wr == 1) PG8_BAR; }
    }
    PG8_WAIT_V(0);
    if constexpr (!ALIGN_EPI) { if (wr == 0) PG8_BAR; }
    PG8_BAR;
    if constexpr (Epi::AFTER_DRAIN) { E.fused(acc, cur, wr, wc, fr, fq, lds, wid, lane); S.done(cur); }
#undef PG8_SA
#undef PG8_SB
#undef PG8_STAGE
#undef PG8_LDA
#undef PG8_LDB
#undef PG8_MMA
#undef PG8_WAIT_V
#undef PG8_WAIT_L
#undef PG8_BAR
#undef PG8_SCHED
}
__device__ __forceinline__ void st_bf16x4(bf16_t* p, f32x4 v) { u32x2 w; w.x = cvtpk(v[0], v[1]); w.y = cvtpk(v[2], v[3]); *(u32x2*)p = w; }

struct EpiBf {
    static constexpr bool PERM = false, AFTER_DRAIN = false;
    bf16_t* O; int ldc; float scale;
    __device__ __forceinline__ void operator()(const f32x4 (&acc)[2][2][4][2], const Unit& u, int wr, int wc, int fr, int fq) const {
#pragma unroll
        for (int ai = 0; ai < 2; ++ai)
#pragma unroll
            for (int m = 0; m < 4; ++m) {
                const size_t row = (size_t)(u.pm * BM + ai * HALF + wr * 64 + m * 16 + fr);
#pragma unroll
                for (int bj = 0; bj < 2; ++bj)
#pragma unroll
                    for (int n = 0; n < 2; ++n) st_bf16x4(O + row * ldc + u.pn * BM + bj * HALF + wc * 32 + n * 16 + 4 * fq, acc[ai][bj][m][n] * scale);
            }
    }
};
struct EpiP1 {
    static constexpr bool PERM = false, AFTER_DRAIN = false;
    bf16_t *U, *Q, *KV, *QI, *KI, *GP, *GA;
    __device__ __forceinline__ void operator()(const f32x4 (&acc)[2][2][4][2], const Unit& u, int wr, int wc, int fr, int fq) const {
        const int pn = u.pn; bf16_t* base; int ldc, c0; float sc = 1.f;
        if (pn < 2) { base = U; ldc = 512; c0 = pn * 256; }
        else if (pn < 6) { base = Q; ldc = 1024; c0 = (pn - 2) * 256; sc = 0.08838834764831845f * 1.4426950408889634f; }
        else if (pn == 6) { base = KV; ldc = 256; c0 = 0; }
        else if (pn == 7) { base = QI; ldc = 256; c0 = 0; }
        else if (pn == 8) { base = KI; ldc = 256; c0 = 0; }
        else if (pn < 13) { base = GP; ldc = 1024; c0 = (pn - 9) * 256; }
        else { base = GA; ldc = 1024; c0 = (pn - 13) * 256; }
#pragma unroll
        for (int ai = 0; ai < 2; ++ai)
#pragma unroll
            for (int m = 0; m < 4; ++m) {
                const size_t row = (size_t)(u.pm * BM + ai * HALF + wr * 64 + m * 16 + fr);
#pragma unroll
                for (int bj = 0; bj < 2; ++bj)
#pragma unroll
                    for (int n = 0; n < 2; ++n) st_bf16x4(base + row * ldc + c0 + bj * HALF + wc * 32 + n * 16 + 4 * fq, acc[ai][bj][m][n] * sc);
            }
    }
};
struct EpiMerge {
    static constexpr bool PERM = false, AFTER_DRAIN = false;
    const bf16_t *AB, *GP, *GA; bf16_t* MG;
    __device__ __forceinline__ void operator()(const f32x4 (&acc)[2][2][4][2], const Unit& u, int wr, int wc, int fr, int fq) const {
#pragma unroll
        for (int ai = 0; ai < 2; ++ai)
#pragma unroll
            for (int m = 0; m < 4; ++m) {
                const size_t row = (size_t)(u.pm * BM + ai * HALF + wr * 64 + m * 16 + fr);
#pragma unroll
                for (int bj = 0; bj < 2; ++bj)
#pragma unroll
                    for (int n = 0; n < 2; ++n) {
                        const size_t off = row * 1024 + u.pn * BM + bj * HALF + wc * 32 + n * 16 + 4 * fq;
                        const u32x2 a = *(const u32x2*)(AB + off), gp = *(const u32x2*)(GP + off), ga = *(const u32x2*)(GA + off);
                        const f32x4 b = acc[ai][bj][m][n]; f32x4 o;
                        o[0] = sigmoidf_(bflo(gp.x)) * bflo(a.x) + sigmoidf_(bflo(ga.x)) * b[0];
                        o[1] = sigmoidf_(bfhi(gp.x)) * bfhi(a.x) + sigmoidf_(bfhi(ga.x)) * b[1];
                        o[2] = sigmoidf_(bflo(gp.y)) * bflo(a.y) + sigmoidf_(bflo(ga.y)) * b[2];
                        o[3] = sigmoidf_(bfhi(gp.y)) * bfhi(a.y) + sigmoidf_(bfhi(ga.y)) * b[3];
                        st_bf16x4(MG + off, o);
                    }
            }
    }
};
struct EpiSwiglu {
    static constexpr bool PERM = false, AFTER_DRAIN = false;
    bf16_t* ACT;
    __device__ __forceinline__ void operator()(const f32x4 (&acc)[2][2][4][2], const Unit& u, int wr, int wc, int fr, int fq) const {
#pragma unroll
        for (int ai = 0; ai < 2; ++ai)
#pragma unroll
            for (int m = 0; m < 4; ++m) {
                const size_t row = (size_t)(u.pm * BM + ai * HALF + wr * 64 + m * 16 + fr);
#pragma unroll
                for (int n = 0; n < 2; ++n) {
                    const f32x4 gt = acc[ai][0][m][n], up = acc[ai][1][m][n]; f32x4 o;
#pragma unroll
                    for (int i = 0; i < 4; ++i) o[i] = gt[i] * sigmoidf_(gt[i]) * up[i];
                    st_bf16x4(ACT + row * DFF + u.pn * HALF + wc * 32 + n * 16 + 4 * fq, o);
                }
            }
    }
};
}


typedef float f32x16 __attribute__((ext_vector_type(16)));
typedef short s16x4 __attribute__((ext_vector_type(4)));
constexpr float C2Q = 0.08838834764831845f * 1.4426950408889634f;
constexpr float LOG2E = 1.4426950408889634f;

__device__ __forceinline__ void index_phase(unsigned char* lds, const bf16_t* QI, const bf16_t* KI, unsigned* BMK, int bid, int G) {
    const int tid = threadIdx.x, lane = tid & 63, wave = __builtin_amdgcn_readfirstlane(tid >> 6), r = lane & 31, h = lane >> 5;
    unsigned* hist = (unsigned*)lds; unsigned* res = (unsigned*)(lds + 65536); unsigned* needv = (unsigned*)(lds + 65664);
    unsigned* tieflag = (unsigned*)(lds + 65696); unsigned* cntw = (unsigned*)(lds + 65728);
    for (int i = tid; i < 16384; i += NTHR) hist[i] = 0u;
    __syncthreads();
    for (int it = bid; it < M / 8; it += G) {
        const int tok0 = it * 8, b = tok0 >> 12, t0 = tok0 & (SEQ - 1);
        const int nk = ((t0 + 8 + 255) >> 8) << 5;
        const int ng = nk >> 5, wbase = wave * nk;
        if (tid < 8) needv[tid] = 256u;
        if (tid == 8) tieflag[0] = 0u;
        bf16x8 aq[4];
#pragma unroll
        for (int s = 0; s < 4; ++s) aq[s] = *(const bf16x8*)(QI + (size_t)(tok0 + (r >> 2)) * 256 + (r & 3) * 64 + 16 * s + 8 * h);
        float wv[4][4];
#pragma unroll
        for (int g = 0; g < 4; ++g) { const u32x2 ww = *(const u32x2*)(KI + (size_t)(tok0 + 2 * g + h) * 256 + 64);
            wv[g][0] = bflo(ww.x) * 0.0625f; wv[g][1] = bfhi(ww.x) * 0.0625f; wv[g][2] = bflo(ww.y) * 0.0625f; wv[g][3] = bfhi(ww.y) * 0.0625f; }
        unsigned u[16][4];
#pragma unroll
        for (int gi = 0; gi < 16; ++gi) {
            if (gi < ng) {
                const int key = wbase + 32 * gi + r;
                const bf16_t* kr = KI + (size_t)(b * SEQ + key) * 256 + 8 * h;
                f32x16 c = {};
#pragma unroll
                for (int s = 0; s < 4; ++s) { const bf16x8 kb = *(const bf16x8*)(kr + 16 * s); c = __builtin_amdgcn_mfma_f32_32x32x16_bf16(aq[s], kb, c, 0, 0, 0); }
#pragma unroll
                for (int g = 0; g < 4; ++g) {
                    float sc = wv[g][0] * fmaxf(c[4 * g], 0.f) + wv[g][1] * fmaxf(c[4 * g + 1], 0.f) + wv[g][2] * fmaxf(c[4 * g + 2], 0.f) + wv[g][3] * fmaxf(c[4 * g + 3], 0.f);
                    sc += 0.0f;
                    u[gi][g] = (key <= t0 + 2 * g + h) ? fkey(sc) : 0u;
                }
            } else { u[gi][0] = 0u; u[gi][1] = 0u; u[gi][2] = 0u; u[gi][3] = 0u; }
        }
        unsigned tau[4] = {1u, 1u, 1u, 1u}, need[4] = {0u, 0u, 0u, 0u};
        bool tie = false;
        if (t0 >= 256) {
            tau[0] = 0u; tau[1] = 0u; tau[2] = 0u; tau[3] = 0u;
#pragma unroll 1
            for (int L = 0; L < 3; ++L) {
                const int shift = L == 0 ? 21 : (L == 1 ? 10 : 0);
                const unsigned himask = L == 0 ? 0u : (L == 1 ? 0xFFE00000u : 0xFFFFFC00u), dmask = L < 2 ? 2047u : 1023u;
#pragma unroll
                for (int gi = 0; gi < 16; ++gi) if (gi < ng) {
#pragma unroll
                    for (int g = 0; g < 4; ++g) { const unsigned uu = u[gi][g];
                        if (uu != 0u && ((uu ^ tau[g]) & himask) == 0u) atomicAdd(&hist[(2 * g + h) * 2048 + ((uu >> shift) & dmask)], 1u); }
                }
                __syncthreads();
                {
                    unsigned* hb = hist + wave * 2048 + (2016 - 32 * lane);
                    unsigned c[32];
#pragma unroll
                    for (int q = 0; q < 8; ++q) { const u32x4 v = *(const u32x4*)(hb + 4 * q); c[4 * q] = v.x; c[4 * q + 1] = v.y; c[4 * q + 2] = v.z; c[4 * q + 3] = v.w; *(u32x4*)(hb + 4 * q) = (u32x4){0u, 0u, 0u, 0u}; }
                    unsigned tot = 0u;
#pragma unroll
                    for (int q = 0; q < 32; ++q) tot += c[q];
                    unsigned cum = tot;
#pragma unroll
                    for (int o = 1; o < 64; o <<= 1) { const unsigned v = __shfl_up(cum, o); if (lane >= o) cum += v; }
                    const unsigned nd = needv[wave];
                    const unsigned long long bal = __ballot(cum >= nd);
                    const int first = bal ? (__ffsll((long long)bal) - 1) : 63;
                    if (lane == first) {
                        unsigned rem = nd - (cum - tot), dig = 0u, ce = 0u; bool found = false;
#pragma unroll
                        for (int q = 31; q >= 0; --q) { if (!found) { if (rem <= c[q]) { found = true; dig = (unsigned)(2016 - 32 * lane + q); ce = c[q]; } else rem -= c[q]; } }
                        res[wave * 4 + 0] = dig; res[wave * 4 + 1] = rem; res[wave * 4 + 2] = ce; needv[wave] = rem;
                        if (L == 2 && rem < ce) atomicOr(tieflag, 1u);
                    }
                }
                __syncthreads();
#pragma unroll
                for (int g = 0; g < 4; ++g) { tau[g] |= res[(2 * g + h) * 4 + 0] << shift; need[g] = res[(2 * g + h) * 4 + 1]; }
            }
            tie = tieflag[0] != 0u;
        }
        if (!tie) {
#pragma unroll
            for (int gi = 0; gi < 16; ++gi) if (gi < ng) {
#pragma unroll
                for (int g = 0; g < 4; ++g) { const unsigned long long bal = __ballot(u[gi][g] >= tau[g]);
                    if (lane == 0) { BMK[(size_t)(tok0 + 2 * g) * 128 + ((wbase + 32 * gi) >> 5)] = (unsigned)bal; BMK[(size_t)(tok0 + 2 * g + 1) * 128 + ((wbase + 32 * gi) >> 5)] = (unsigned)(bal >> 32); } }
            }
        } else {
            unsigned cnt[4] = {0u, 0u, 0u, 0u};
#pragma unroll
            for (int gi = 0; gi < 16; ++gi) if (gi < ng) {
#pragma unroll
                for (int g = 0; g < 4; ++g) { const unsigned long long bal = __ballot(u[gi][g] == tau[g]); cnt[g] += __popc(h ? (unsigned)(bal >> 32) : (unsigned)bal); }
            }
            if (r == 0) {
#pragma unroll
                for (int g = 0; g < 4; ++g) cntw[(2 * g + h) * 8 + wave] = cnt[g]; }
            __syncthreads();
            unsigned run[4];
#pragma unroll
            for (int g = 0; g < 4; ++g) { unsigned a = 0u; for (int w2 = 0; w2 < wave; ++w2) a += cntw[(2 * g + h) * 8 + w2]; run[g] = a; }
#pragma unroll
            for (int gi = 0; gi < 16; ++gi) if (gi < ng) {
#pragma unroll
                for (int g = 0; g < 4; ++g) { const unsigned uu = u[gi][g];
                    const unsigned long long be = __ballot(uu == tau[g]); const unsigned mine = h ? (unsigned)(be >> 32) : (unsigned)be;
                    const unsigned rank = run[g] + __popc(mine & ((1u << r) - 1u)); run[g] += __popc(mine);
                    const bool sel = (uu > tau[g]) || (uu == tau[g] && rank < need[g]);
                    const unsigned long long bal = __ballot(sel);
                    if (lane == 0) { BMK[(size_t)(tok0 + 2 * g) * 128 + ((wbase + 32 * gi) >> 5)] = (unsigned)bal; BMK[(size_t)(tok0 + 2 * g + 1) * 128 + ((wbase + 32 * gi) >> 5)] = (unsigned)(bal >> 32); } }
            }
        }
        __syncthreads();
    }
}


constexpr int KP = 272, VP = 320, KT_BYTES = 64 * KP, VT_BYTES = 64 * VP, ABUF_BYTES = KT_BYTES + VT_BYTES;
constexpr int ATT_LUT_OFF = 2 * ABUF_BYTES;
typedef short v4i16_t __attribute__((ext_vector_type(4)));
__device__ __forceinline__ s16x4 vtr(const LAS unsigned char* p) { return __builtin_bit_cast(s16x4, __builtin_amdgcn_ds_read_tr16_b64_v4i16((LAS v4i16_t*)p)); }

template <bool MASKED>
__device__ __forceinline__ void attn_item(LAS unsigned char* lds, const bf16_t* qrow  , const bf16_t* Kg, const bf16_t* Vg, int kvpitch  ,
                                          int nt, const unsigned* mrow  , int tpos  , int T0, int head, bf16_t* orow) {
    const int tid = threadIdx.x, lane = tid & 63, r = lane & 31, h = lane >> 5;
    bf16x8 qf[8];
#pragma unroll
    for (int s = 0; s < 8; ++s) qf[s] = *(const bf16x8*)(qrow + 16 * s + 8 * h);
    const int srow0 = tid >> 4, scol = tid & 15;
    u32x4 sk[2], sv[2];
#pragma unroll
    for (int i = 0; i < 2; ++i) { sk[i] = *(const u32x4*)(Kg + (size_t)(srow0 + 32 * i) * kvpitch + scol * 8); sv[i] = *(const u32x4*)(Vg + (size_t)(srow0 + 32 * i) * kvpitch + scol * 8); }
#pragma unroll
    for (int i = 0; i < 2; ++i) { *(LAS u32x4*)(lds + (srow0 + 32 * i) * KP + scol * 16) = sk[i]; *(LAS u32x4*)(lds + KT_BYTES + (srow0 + 32 * i) * VP + scol * 16) = sv[i]; }
    __syncthreads();
    f32x16 o[4];
#pragma unroll
    for (int d = 0; d < 4; ++d) o[d] = (f32x16){};
    float mrun = -1e30f, lsum = 0.f;
    const int koff = r * KP + 16 * h;
    const int voff = (4 * h + ((lane & 15) >> 2)) * VP + (((lane >> 4) & 1) * 16 + (lane & 3) * 4) * 2;
    for (int kt = 0; kt < nt; ++kt) {
        LAS unsigned char* buf = lds + (kt & 1) * ABUF_BYTES;
        const bool more = kt + 1 < nt;
        if (more) {
#pragma unroll
            for (int i = 0; i < 2; ++i) { sk[i] = *(const u32x4*)(Kg + (size_t)((kt + 1) * 64 + srow0 + 32 * i) * kvpitch + scol * 8); sv[i] = *(const u32x4*)(Vg + (size_t)((kt + 1) * 64 + srow0 + 32 * i) * kvpitch + scol * 8); }
        }
        u32x2 mw = {0u, 0u};
        if (MASKED) mw = *(const u32x2*)(mrow + 2 * kt);
        f32x16 p0 = {}, p1 = {};
#pragma unroll
        for (int s = 0; s < 8; ++s) {
            const bf16x8 k0 = *(const LAS bf16x8*)(buf + koff + 32 * s), k1 = *(const LAS bf16x8*)(buf + koff + 32 * KP + 32 * s);
            p0 = __builtin_amdgcn_mfma_f32_32x32x16_bf16(k0, qf[s], p0, 0, 0, 0);
            p1 = __builtin_amdgcn_mfma_f32_32x32x16_bf16(k1, qf[s], p1, 0, 0, 0);
        }
        if (MASKED) {
            const int k0i = kt * 64;
            if (k0i + 63 + 128 > T0) {
                const LAS float* lutb = (const LAS float*)(lds + ATT_LUT_OFF) + head * 129;
                const int base = tpos - k0i - 4 * h;
#pragma unroll
                for (int i = 0; i < 16; ++i) { const int pos = (i & 3) + 8 * (i >> 2);
                    unsigned d0 = (unsigned)(base - pos), d1 = (unsigned)(base - pos - 32); d0 = d0 < 128u ? d0 : 128u; d1 = d1 < 128u ? d1 : 128u;
                    p0[i] += lutb[d0]; p1[i] += lutb[d1]; }
            }
            const unsigned w0 = mw.x >> (4 * h), w1 = mw.y >> (4 * h);
#pragma unroll
            for (int i = 0; i < 16; ++i) { const int pos = (i & 3) + 8 * (i >> 2);
                p0[i] = ((w0 >> pos) & 1u) ? p0[i] : -INFINITY; p1[i] = ((w1 >> pos) & 1u) ? p1[i] : -INFINITY; }
        }
        float mx = fmaxf(p0[0], p1[0]);
#pragma unroll
        for (int i = 1; i < 16; ++i) mx = fmaxf(mx, fmaxf(p0[i], p1[i]));
        mx = fmaxf(mx, __shfl_xor(mx, 32));
        const float mnew = fmaxf(mrun, mx), alpha = __builtin_amdgcn_exp2f(mrun - mnew);
        mrun = mnew;
        float ps = 0.f;
#pragma unroll
        for (int i = 0; i < 16; ++i) { p0[i] = __builtin_amdgcn_exp2f(p0[i] - mnew); p1[i] = __builtin_amdgcn_exp2f(p1[i] - mnew); ps += p0[i] + p1[i]; }
        lsum = lsum * alpha + ps;
#pragma unroll
        for (int d = 0; d < 4; ++d)
#pragma unroll
            for (int i = 0; i < 16; ++i) o[d][i] *= alpha;
        bf16x8 pb[4];
        { u32x4 w;
          w.x = cvtpk(p0[0], p0[1]); w.y = cvtpk(p0[2], p0[3]); w.z = cvtpk(p0[4], p0[5]); w.w = cvtpk(p0[6], p0[7]); pb[0] = __builtin_bit_cast(bf16x8, w);
          w.x = cvtpk(p0[8], p0[9]); w.y = cvtpk(p0[10], p0[11]); w.z = cvtpk(p0[12], p0[13]); w.w = cvtpk(p0[14], p0[15]); pb[1] = __builtin_bit_cast(bf16x8, w);
          w.x = cvtpk(p1[0], p1[1]); w.y = cvtpk(p1[2], p1[3]); w.z = cvtpk(p1[4], p1[5]); w.w = cvtpk(p1[6], p1[7]); pb[2] = __builtin_bit_cast(bf16x8, w);
          w.x = cvtpk(p1[8], p1[9]); w.y = cvtpk(p1[10], p1[11]); w.z = cvtpk(p1[12], p1[13]); w.w = cvtpk(p1[14], p1[15]); pb[3] = __builtin_bit_cast(bf16x8, w); }
        const LAS unsigned char* vb = buf + KT_BYTES + voff;
#pragma unroll
        for (int d = 0; d < 4; ++d)
#pragma unroll
            for (int s2 = 0; s2 < 4; ++s2) {
                const s16x4 lo = vtr(vb + (16 * s2) * VP + 64 * d), hi = vtr(vb + (16 * s2 + 8) * VP + 64 * d);
                const bf16x8 vf = (bf16x8){lo[0], lo[1], lo[2], lo[3], hi[0], hi[1], hi[2], hi[3]};
                o[d] = __builtin_amdgcn_mfma_f32_32x32x16_bf16(vf, pb[s2], o[d], 0, 0, 0);
            }
        if (more) {
            LAS unsigned char* nb = lds + ((kt + 1) & 1) * ABUF_BYTES;
#pragma unroll
            for (int i = 0; i < 2; ++i) { *(LAS u32x4*)(nb + (srow0 + 32 * i) * KP + scol * 16) = sk[i]; *(LAS u32x4*)(nb + KT_BYTES + (srow0 + 32 * i) * VP + scol * 16) = sv[i]; }
        }
        __syncthreads();
    }
    lsum += __shfl_xor(lsum, 32);
    const float inv = 1.f / lsum;
#pragma unroll
    for (int d = 0; d < 4; ++d)
#pragma unroll
        for (int g = 0; g < 4; ++g) { u32x2 w; w.x = cvtpk(o[d][4 * g] * inv, o[d][4 * g + 1] * inv); w.y = cvtpk(o[d][4 * g + 2] * inv, o[d][4 * g + 3] * inv);
            *(u32x2*)(orow + 32 * d + 8 * g + 4 * h) = w; }
}

#ifdef USE_SIMPLE_GEMM
#define GEMM_CALL(g, S, E) pg8::gemm_simple(g, S, E)
#else
#define GEMM_CALL(g, S, E) pg8::gemm_phase<decltype(E), pg8::StaticOrder, true, true>((LAS unsigned char*)lds, g, S, E)
#endif
#ifndef NAIVE_INDEX
#define NAIVE_INDEX 0
#endif
#ifndef NAIVE_ATTN
#define NAIVE_ATTN 0
#endif
#ifndef NAIVE_MEM
#define NAIVE_MEM 0
#endif
struct Args { const float* in[21]; float* out; unsigned char* ws; };

__device__ __forceinline__ void tr_item(const float* W, int ldw, int c0, int ncols, int K, bf16_t* WT, int r0, float* scr, int kb, int nb, int lane) {
    const int k0 = 64 * kb, n0 = 32 * nb;
#pragma unroll 8
    for (int i = 0; i < 32; ++i) { const int kk = 2 * i + (lane >> 5); const int nn = n0 + (lane & 31);
        scr[kk * 33 + (lane & 31)] = nn < ncols ? W[(size_t)(k0 + kk) * ldw + c0 + nn] : 0.f; }
    asm volatile("s_waitcnt lgkmcnt(0)" ::: "memory");
    const int c = lane & 7;
#pragma unroll
    for (int j = 0; j < 4; ++j) { const int n = (lane >> 3) + 8 * j; const float* s = scr + (8 * c) * 33 + n;
        u32x4 o; o.x = cvtpk(s[0 * 33], s[1 * 33]); o.y = cvtpk(s[2 * 33], s[3 * 33]); o.z = cvtpk(s[4 * 33], s[5 * 33]); o.w = cvtpk(s[6 * 33], s[7 * 33]);
        *(u32x4*)(WT + (size_t)(r0 + n0 + n) * K + k0 + 8 * c) = o; }
    asm volatile("s_waitcnt lgkmcnt(0)" ::: "memory");
}
__device__ __forceinline__ void rms_row_to_bf16(const float* xrow, const float* g, bf16_t* orow, int lane) {
    f32x4 v[4]; float s = 0.f;
#pragma unroll
    for (int j = 0; j < 4; ++j) { v[j] = *(const f32x4*)(xrow + 4 * lane + 256 * j); s += (v[j][0] * v[j][0] + v[j][1] * v[j][1]) + (v[j][2] * v[j][2] + v[j][3] * v[j][3]); }
    const float rstd = rsqrtf(wave_sum(s) * (1.f / DM) + EPS);
#pragma unroll
    for (int j = 0; j < 4; ++j) { const f32x4 gg = *(const f32x4*)(g + 4 * lane + 256 * j);
        u32x2 w; w.x = cvtpk(v[j][0] * rstd * gg[0], v[j][1] * rstd * gg[1]); w.y = cvtpk(v[j][2] * rstd * gg[2], v[j][3] * rstd * gg[3]);
        *(u32x2*)(orow + 4 * lane + 256 * j) = w; }
}
__device__ __forceinline__ void res_norm_row(const float* xin, const bf16_t* mix, const float* gpost, float* xo, const float* gpre, bf16_t* h, int lane) {
    f32x4 mv[4]; float s = 0.f;
#pragma unroll
    for (int j = 0; j < 4; ++j) { const u32x2 w = *(const u32x2*)(mix + 4 * lane + 256 * j); mv[j] = (f32x4){bflo(w.x), bfhi(w.x), bflo(w.y), bfhi(w.y)};
        s += (mv[j][0] * mv[j][0] + mv[j][1] * mv[j][1]) + (mv[j][2] * mv[j][2] + mv[j][3] * mv[j][3]); }
    const float rstd = rsqrtf(wave_sum(s) * (1.f / DM) + EPS);
    f32x4 xv[4]; float s2 = 0.f;
#pragma unroll
    for (int j = 0; j < 4; ++j) { const f32x4 gg = *(const f32x4*)(gpost + 4 * lane + 256 * j); const f32x4 xi = *(const f32x4*)(xin + 4 * lane + 256 * j);
        xv[j] = xi + mv[j] * rstd * gg; *(f32x4*)(xo + 4 * lane + 256 * j) = xv[j];
        s2 += (xv[j][0] * xv[j][0] + xv[j][1] * xv[j][1]) + (xv[j][2] * xv[j][2] + xv[j][3] * xv[j][3]); }
    if (h) {
        const float r2 = rsqrtf(wave_sum(s2) * (1.f / DM) + EPS);
#pragma unroll
        for (int j = 0; j < 4; ++j) { const f32x4 gg = *(const f32x4*)(gpre + 4 * lane + 256 * j);
            u32x2 w; w.x = cvtpk(xv[j][0] * r2 * gg[0], xv[j][1] * r2 * gg[1]); w.y = cvtpk(xv[j][2] * r2 * gg[2], xv[j][3] * r2 * gg[3]);
            *(u32x2*)(h + 4 * lane + 256 * j) = w; }
    }
}

__global__ void __launch_bounds__(NTHR, 2) fwd_kernel(Args args) {
    extern __shared__ __attribute__((aligned(16))) unsigned char lds[];
    const int tid = threadIdx.x, lane = tid & 63, wave = __builtin_amdgcn_readfirstlane(tid >> 6);
    const int G = gridDim.x, bid = blockIdx.x;
    unsigned char* ws = args.ws;
    unsigned* ctl = (unsigned*)(ws + WS_CTL);
    for (int u = tid; u < (LDS_BYTES - LDSCTL_OFF) / 4; u += NTHR) ((unsigned*)(lds + LDSCTL_OFF))[u] = 0u;
    __syncthreads();
    XcdBarrier bar = xcd_barrier_post(ctl + CW_BAR, (volatile LAS unsigned*)((LAS unsigned char*)lds + MISC_OFF + 32));

    const float* x = args.in[0]; const float* mem = args.in[1];
    const float* g_mix_pre = args.in[2]; const float* g_mix_post = args.in[3];
    const float* w_in = args.in[4]; const float* pool_w = args.in[5]; const float* pool_scale = args.in[6];
    const float* w_proj_pool = args.in[7]; const float* w_proj_attn = args.in[8]; const float* rel_bias = args.in[9];
    const float* w_out = args.in[10]; const float* g_mem_pre = args.in[11]; const float* g_mem_kv = args.in[12]; const float* g_mem_post = args.in[13];
    const float* w_q_mem = args.in[14]; const float* w_kv_mem = args.in[15]; const float* w_o_mem = args.in[16];
    const float* g_ffn_pre = args.in[17]; const float* g_ffn_post = args.in[18]; const float* w_gate_up = args.in[19]; const float* w_down = args.in[20];
    float* out = args.out;
    bf16_t* Win_t = (bf16_t*)(ws + WS_WIN); bf16_t* Weff_t = (bf16_t*)(ws + WS_WEFF); bf16_t* Wpa_t = (bf16_t*)(ws + WS_WPA); bf16_t* Wout_t = (bf16_t*)(ws + WS_WOUT);
    bf16_t* Wq_t = (bf16_t*)(ws + WS_WQ); bf16_t* Wkv_t = (bf16_t*)(ws + WS_WKV); bf16_t* Wo_t = (bf16_t*)(ws + WS_WO); bf16_t* Wgu_t = (bf16_t*)(ws + WS_WGU); bf16_t* Wdn_t = (bf16_t*)(ws + WS_WDN);
    bf16_t* MEMN = (bf16_t*)(ws + WS_MEMN); bf16_t* KVM = (bf16_t*)(ws + WS_KVM); unsigned* BMK = (unsigned*)(ws + WS_BM);
    bf16_t* H = (bf16_t*)(ws + WS_H); bf16_t* ATT = H;
    bf16_t* U = (bf16_t*)(ws + WS_U); bf16_t* Q = (bf16_t*)(ws + WS_Q); bf16_t* KV = (bf16_t*)(ws + WS_KV); bf16_t* QI = (bf16_t*)(ws + WS_QI); bf16_t* KI = (bf16_t*)(ws + WS_KI);
    bf16_t* GP = (bf16_t*)(ws + WS_GP); bf16_t* GA = (bf16_t*)(ws + WS_GA); bf16_t* PL = (bf16_t*)(ws + WS_PL); bf16_t* AB = (bf16_t*)(ws + WS_AB);
    bf16_t* MG = (bf16_t*)(ws + WS_MG); bf16_t* MIX = (bf16_t*)(ws + WS_MIX); bf16_t* QM = (bf16_t*)(ws + WS_QM); bf16_t* OM = (bf16_t*)(ws + WS_OM); bf16_t* ACT = (bf16_t*)(ws + WS_ACT);

    const int gw = bid * NWAVES + wave, NGW = G * NWAVES;

    {
        float* scr = (float*)(lds + wave * 16384);
        constexpr int I_A = 16 * 67, I_B = 16 * 64, I_PA = 16 * 32, I_OUT = 16 * 32, I_Q = 16 * 16, I_KV = 16 * 32, I_O = 8 * 32, I_GU = 16 * 176, I_DN = 44 * 32;
        constexpr int NITEMS = I_A + I_B + I_PA + I_OUT + I_Q + I_KV + I_O + I_GU + I_DN;
        for (int it = gw; it < NITEMS; it += NGW) {
            int r = it;
            if (r < I_A) { tr_item(w_in, IN_W, 0, 2116, 1024, Win_t, 0, scr, r / 67, r % 67, lane); continue; } r -= I_A;
            if (r < I_B) { tr_item(w_in, IN_W, 2116, 2048, 1024, Win_t, 2304, scr, r / 64, r % 64, lane); continue; } r -= I_B;
            if (r < I_PA) { tr_item(w_proj_attn, 1024, 0, 1024, 1024, Wpa_t, 0, scr, r / 32, r % 32, lane); continue; } r -= I_PA;
            if (r < I_OUT) { tr_item(w_out, 1024, 0, 1024, 1024, Wout_t, 0, scr, r / 32, r % 32, lane); continue; } r -= I_OUT;
            if (r < I_Q) { tr_item(w_q_mem, 512, 0, 512, 1024, Wq_t, 0, scr, r / 16, r % 16, lane); continue; } r -= I_Q;
            if (r < I_KV) { tr_item(w_kv_mem, 1024, 0, 1024, 1024, Wkv_t, 0, scr, r / 32, r % 32, lane); continue; } r -= I_KV;
            if (r < I_O) { tr_item(w_o_mem, 1024, 0, 1024, 512, Wo_t, 0, scr, r / 32, r % 32, lane); continue; } r -= I_O;
            if (r < I_GU) { const int kb = r / 176, nb = r % 176; const int n0 = 32 * nb, pn = n0 / 256, half = (n0 % 256) / 128, jj0 = n0 % 128;
                const int src = half * DFF + pn * 128 + jj0;
                tr_item(w_gate_up, 2 * DFF, src - n0, 1 << 30, 1024, Wgu_t, 0, scr, kb, nb, lane); continue; } r -= I_GU;
            tr_item(w_down, 1024, 0, 1024, DFF, Wdn_t, 0, scr, r / 32, r % 32, lane);
        }
        for (int i = bid * NTHR + tid; i < 160 * 1024 / 8; i += G * NTHR) *(u32x4*)(Win_t + (size_t)2144 * 1024 + (size_t)i * 8) = (u32x4){0u, 0u, 0u, 0u};
        for (int i = bid * NTHR + tid; i < 512 * 1024; i += G * NTHR) {
            const int k = i >> 10, n = i & 1023, gq = k >> 7;
            const float* pw = pool_w + (size_t)k * 128; float acc = 0.f;
            for (int d = 0; d < 128; ++d) acc += pw[d] * pool_scale[gq * 128 + d] * w_proj_pool[(size_t)(gq * 128 + d) * 1024 + n];
            Weff_t[(size_t)n * 512 + k] = f2bf(acc);
        }
        for (int m = gw; m < M + MMEM; m += NGW) {
            if (m < M) rms_row_to_bf16(x + (size_t)m * DM, g_mix_pre, H + (size_t)m * DM, lane);
            else rms_row_to_bf16(mem + (size_t)(m - M) * DM, g_mem_kv, MEMN + (size_t)(m - M) * DM, lane);
        }
    }
    xcd_barrier(bar);

    {
        { pg8::Gemm g{MEMN, Wkv_t, MMEM, 1024, 1024}; pg8::StaticOrder S; S.init(MMEM, 1024, G, bid); pg8::EpiBf E{KVM, 1024, 1.f}; GEMM_CALL(g, S, E); }
        { pg8::Gemm g{H, Win_t, M, IN_PAD, 1024}; pg8::StaticOrder S; S.init(M, IN_PAD, G, bid); pg8::EpiP1 E{U, Q, KV, QI, KI, GP, GA}; GEMM_CALL(g, S, E); }
    }
    xcd_barrier(bar);

    {
        for (int i = bid * NTHR + tid; i < M * 64; i += G * NTHR) {
            const int tok = i >> 6, c8 = (i & 63) * 8, t = tok & (SEQ - 1), w = 2 << (c8 >> 7);
            const u32x4 cur = *(const u32x4*)(U + (size_t)tok * 512 + c8);
            float s[8], c[8]; c[0] = bflo(cur.x); c[1] = bfhi(cur.x); c[2] = bflo(cur.y); c[3] = bfhi(cur.y); c[4] = bflo(cur.z); c[5] = bfhi(cur.z); c[6] = bflo(cur.w); c[7] = bfhi(cur.w);
#pragma unroll
            for (int e = 0; e < 8; ++e) s[e] = c[e];
            const int cnt = (t + 1 < w) ? t + 1 : w;
            for (int j = 1; j < cnt; ++j) { const u32x4 p = *(const u32x4*)(U + (size_t)(tok - j) * 512 + c8);
                s[0] += bflo(p.x); s[1] += bfhi(p.x); s[2] += bflo(p.y); s[3] += bfhi(p.y); s[4] += bflo(p.z); s[5] += bfhi(p.z); s[6] += bflo(p.w); s[7] += bfhi(p.w); }
            const float inv = 1.f / (float)cnt; u32x4 o;
            o.x = cvtpk(s[0] * inv - c[0], s[1] * inv - c[1]); o.y = cvtpk(s[2] * inv - c[2], s[3] * inv - c[3]);
            o.z = cvtpk(s[4] * inv - c[4], s[5] * inv - c[5]); o.w = cvtpk(s[6] * inv - c[6], s[7] * inv - c[7]);
            *(u32x4*)(PL + (size_t)tok * 512 + c8) = o;
        }
#if NAIVE_INDEX
        unsigned* sc = (unsigned*)lds;
        unsigned* hist = (unsigned*)(lds + 16384);
        float* qs = (float*)(lds + 16384 + 1024);
        float* wsv = (float*)(lds + 16384 + 2048);
        unsigned* sel = (unsigned*)(lds + 16384 + 2048 + 64);
        for (int tok = bid; tok < M; tok += G) {
            const int b = tok >> 12, t = tok & (SEQ - 1), n = t + 1;
            if (tid < 256) qs[tid] = bf2f(QI[(size_t)tok * 256 + tid]);
            if (tid < 4) wsv[tid] = bf2f(KI[(size_t)tok * 256 + 64 + tid]) * 0.5f;
            __syncthreads();
            for (int s = tid; s < n; s += NTHR) {
                asm volatile("" ::: "memory");
                const bf16_t* kr = KI + (size_t)(b * SEQ + s) * 256;
                float d0 = 0.f, d1 = 0.f, d2 = 0.f, d3 = 0.f;
#pragma unroll
                for (int j = 0; j < 8; ++j) { const u32x4 kw = *(const u32x4*)(kr + 8 * j);
                    const float kf[8] = {bflo(kw.x), bfhi(kw.x), bflo(kw.y), bfhi(kw.y), bflo(kw.z), bfhi(kw.z), bflo(kw.w), bfhi(kw.w)};
#pragma unroll
                    for (int e = 0; e < 8; ++e) { d0 += qs[8 * j + e] * kf[e]; d1 += qs[64 + 8 * j + e] * kf[e]; d2 += qs[128 + 8 * j + e] * kf[e]; d3 += qs[192 + 8 * j + e] * kf[e]; } }
                float score = wsv[0] * fmaxf(d0 * 0.125f, 0.f) + wsv[1] * fmaxf(d1 * 0.125f, 0.f) + wsv[2] * fmaxf(d2 * 0.125f, 0.f) + wsv[3] * fmaxf(d3 * 0.125f, 0.f);
                score += 0.0f;
                sc[s] = fkey(score);
            }
            __syncthreads();
            unsigned tau = 0u; int cutoff = n - 1;
            if (n > 256) {
                unsigned prefix = 0u; unsigned need = 256u; unsigned ceq = 0u;
                for (int p = 0; p < 4; ++p) {
                    const int shift = 24 - 8 * p;
                    if (tid < 256) hist[tid] = 0u;
                    __syncthreads();
                    for (int s = tid; s < n; s += NTHR) { const unsigned key = sc[s];
                        if (p == 0 || (key >> (shift + 8)) == (prefix >> (shift + 8))) atomicAdd(&hist[(key >> shift) & 255u], 1u); }
                    __syncthreads();
                    if (tid == 0) { unsigned nd = need; int d = 255; for (; d > 0; --d) { const unsigned c = hist[d]; if (nd <= c) break; nd -= c; } sel[0] = (unsigned)d; sel[1] = nd; sel[3] = hist[d]; }
                    __syncthreads();
                    prefix |= sel[0] << shift; need = sel[1]; ceq = sel[3];
                    __syncthreads();
                }
                tau = prefix;
                if (need < ceq) {
                    if (tid == 0) { unsigned c = 0; int s = 0; for (; s < n; ++s) { if (sc[s] == tau) { if (++c == need) break; } } sel[2] = (unsigned)s; }
                    __syncthreads();
                    cutoff = (int)sel[2];
                }
            }
#pragma unroll
            for (int i = 0; i < 8; ++i) {
                const int s = i * NTHR + tid; bool f = false;
                if (s < n) { const unsigned key = sc[s]; f = (key > tau) || (key == tau && s <= cutoff); }
                const unsigned long long bm = __ballot(f);
                if (lane == 0) { *(u32x2*)(BMK + (size_t)tok * 128 + (i * NTHR + wave * 64) / 32) = (u32x2){(unsigned)bm, (unsigned)(bm >> 32)}; }
            }
            __syncthreads();
        }
    #else
        index_phase(lds, QI, KI, BMK, bid, G);
#endif
    }
    xcd_barrier(bar);

    {
        { pg8::Gemm g{PL, Weff_t, M, 1024, 512}; pg8::StaticOrder S; S.init(M, 1024, G, bid); pg8::EpiBf E{AB, 1024, 1.f}; GEMM_CALL(g, S, E); }
#if NAIVE_ATTN
        int* list = (int*)lds;
        unsigned* wbits = (unsigned*)(lds + 1024);
        unsigned* wcnt = (unsigned*)(lds + 1536);
        int* lut = (int*)(lds + 2048);
        float* qs = (float*)(lds + 4096);
        float* ps = (float*)(lds + 8192);
        int* nselp = (int*)(lds + 16384);
        if (tid < 128) { int bk = tid; if (tid >= 16) { const float nf = (float)tid; int lg = 16 + (int)(logf(nf / 16.f) / logf(8.f) * 16.f); bk = lg < 31 ? lg : 31; } lut[tid] = bk; }
        __syncthreads();
        for (int tok = bid; tok < M; tok += G) {
            const int b = tok >> 12, t = tok & (SEQ - 1);
            if (tid < 128) { const unsigned w = (tid * 32 <= t) ? BMK[(size_t)tok * 128 + tid] : 0u; wbits[tid] = w; wcnt[tid] = __popc(w); }
            for (int i = tid; i < 1024; i += NTHR) qs[i] = bf2f(Q[(size_t)tok * 1024 + i]);
            __syncthreads();
            if (tid < 128) { int off = 0; for (int j = 0; j < tid; ++j) off += wcnt[j]; unsigned w = wbits[tid]; int pos = off;
                while (w) { const int bit = __ffs(w) - 1; list[pos++] = tid * 32 + bit; w &= w - 1; }
                if (tid == 127) nselp[0] = pos; }
            __syncthreads();
            const int nsel = nselp[0]; const int h = wave;
            float lg[4]; float mx = -INFINITY;
#pragma unroll
            for (int jj = 0; jj < 4; ++jj) { const int j = lane + 64 * jj; lg[jj] = -INFINITY; asm volatile("" ::: "memory");
                if (j < nsel) { const int s = list[j]; const bf16_t* kr = KV + (size_t)(b * SEQ + s) * 256; float d = 0.f;
#pragma unroll
                    for (int q8 = 0; q8 < 16; ++q8) { const u32x4 kw = *(const u32x4*)(kr + 8 * q8); const float* qq = qs + h * 128 + 8 * q8;
                        d += qq[0] * bflo(kw.x) + qq[1] * bfhi(kw.x) + qq[2] * bflo(kw.y) + qq[3] * bfhi(kw.y) + qq[4] * bflo(kw.z) + qq[5] * bfhi(kw.z) + qq[6] * bflo(kw.w) + qq[7] * bfhi(kw.w); }
                    const int dist = t - s; const int bk = dist < 128 ? lut[dist] : 31;
                    lg[jj] = d * (1.f / LOG2E) + rel_bias[bk * 8 + h]; }
                mx = fmaxf(mx, lg[jj]); }
            mx = wave_max(mx); float sum = 0.f;
#pragma unroll
            for (int jj = 0; jj < 4; ++jj) { lg[jj] = (lg[jj] == -INFINITY) ? 0.f : __expf(lg[jj] - mx); sum += lg[jj]; }
            sum = wave_sum(sum); const float inv = 1.f / sum;
#pragma unroll
            for (int jj = 0; jj < 4; ++jj) ps[h * 256 + lane + 64 * jj] = lg[jj] * inv;
            __syncthreads();
            float a0 = 0.f, a1 = 0.f;
            for (int j = 0; j < nsel; ++j) { const int s = list[j]; const unsigned vw = *(const unsigned*)(KV + (size_t)(b * SEQ + s) * 256 + 128 + 2 * lane); const float p = ps[h * 256 + j];
                a0 += p * bflo(vw); a1 += p * bfhi(vw); }
            *(unsigned*)(ATT + (size_t)tok * 1024 + h * 128 + 2 * lane) = cvtpk(a0, a1);
            __syncthreads();
        }
    #else
        {
            float* lutf = (float*)(lds + ATT_LUT_OFF);
            for (int i = tid; i < 8 * 129; i += NTHR) { const int hh = i / 129, d = i % 129; float v = 0.f;
                if (d < 128) { int bk = d; if (d >= 16) { const int lg = 16 + (int)(logf((float)d / 16.f) / logf(8.f) * 16.f); bk = lg < 31 ? lg : 31; }
                    v = (rel_bias[bk * 8 + hh] - rel_bias[31 * 8 + hh]) * LOG2E; }
                lutf[i] = v; }
            __syncthreads();
            const int r = lane & 31;
            for (int j = bid; j < 512; j += G) {
#pragma unroll 1
                for (int e = 0; e < 2; ++e) {
                    const int idx = e == 0 ? j : 1023 - j;
                    const int tb = 127 - (idx >> 3), b = idx & 7, T0 = tb * 32; const size_t tok = (size_t)b * SEQ + T0 + r;
                    attn_item<true>((LAS unsigned char*)lds, Q + tok * 1024 + wave * 128, KV + (size_t)b * SEQ * 256, KV + (size_t)b * SEQ * 256 + 128, 256, (T0 >> 6) + 1,
                                    BMK + tok * 128, T0 + r, T0, wave, ATT + tok * 1024 + wave * 128);
                }
            }
        }
#endif
    }
    xcd_barrier(bar);

    { pg8::Gemm g{ATT, Wpa_t, M, 1024, 1024}; pg8::StaticOrder S; S.init(M, 1024, G, bid); pg8::EpiMerge E{AB, GP, GA, MG}; GEMM_CALL(g, S, E); }
    xcd_barrier(bar);
    { pg8::Gemm g{MG, Wout_t, M, 1024, 1024}; pg8::StaticOrder S; S.init(M, 1024, G, bid); pg8::EpiBf E{MIX, 1024, 1.f}; GEMM_CALL(g, S, E); }
    xcd_barrier(bar);
    for (int m = gw; m < M; m += NGW) res_norm_row(x + (size_t)m * DM, MIX + (size_t)m * DM, g_mix_post, out + (size_t)m * DM, g_mem_pre, H + (size_t)m * DM, lane);
    xcd_barrier(bar);
    { pg8::Gemm g{H, Wq_t, M, 512, 1024}; pg8::StaticOrder S; S.init(M, 512, G, bid); pg8::EpiBf E{QM, 512, C2Q}; GEMM_CALL(g, S, E); }
    xcd_barrier(bar);
    {
#if NAIVE_MEM
        float* qs = (float*)lds;
        float* ps = (float*)(lds + 4096);
        for (int tp = bid; tp < M / 2; tp += G) {
            for (int i = tid; i < 1024; i += NTHR) qs[i] = bf2f(QM[(size_t)tp * 1024 + i]);
            __syncthreads();
            const int tok = tp * 2 + (wave >> 2), h = wave & 3, b = tok >> 12;
            const float* qq = qs + (wave >> 2) * 512 + h * 128;
            float lg[4]; float mx = -INFINITY;
#pragma unroll
            for (int jj = 0; jj < 4; ++jj) { const int j = lane + 64 * jj; asm volatile("" ::: "memory"); const bf16_t* kr = KVM + (size_t)(b * NMEM + j) * 1024 + h * 128; float d = 0.f;
#pragma unroll
                for (int q8 = 0; q8 < 16; ++q8) { const u32x4 kw = *(const u32x4*)(kr + 8 * q8); const float* q = qq + 8 * q8;
                    d += q[0] * bflo(kw.x) + q[1] * bfhi(kw.x) + q[2] * bflo(kw.y) + q[3] * bfhi(kw.y) + q[4] * bflo(kw.z) + q[5] * bfhi(kw.z) + q[6] * bflo(kw.w) + q[7] * bfhi(kw.w); }
                lg[jj] = d * (1.f / LOG2E); mx = fmaxf(mx, lg[jj]); }
            mx = wave_max(mx); float sum = 0.f;
#pragma unroll
            for (int jj = 0; jj < 4; ++jj) { lg[jj] = __expf(lg[jj] - mx); sum += lg[jj]; }
            sum = wave_sum(sum); const float inv = 1.f / sum;
#pragma unroll
            for (int jj = 0; jj < 4; ++jj) ps[wave * 256 + lane + 64 * jj] = lg[jj] * inv;
            __syncthreads();
            float a0 = 0.f, a1 = 0.f;
            for (int j = 0; j < NMEM; ++j) { const unsigned vw = *(const unsigned*)(KVM + (size_t)(b * NMEM + j) * 1024 + 512 + h * 128 + 2 * lane); const float p = ps[wave * 256 + j];
                a0 += p * bflo(vw); a1 += p * bfhi(vw); }
            *(unsigned*)(OM + (size_t)tok * 512 + h * 128 + 2 * lane) = cvtpk(a0, a1);
            __syncthreads();
        }
    #else
        {
            const int r = lane & 31;
            for (int it = bid; it < 512; it += G) {
                const int b = it >> 6, hh = (it >> 4) & 3, tg = it & 15; const size_t tok = (size_t)b * SEQ + tg * 256 + wave * 32 + r;
                const bf16_t* Kg = KVM + (size_t)b * NMEM * 1024 + hh * 128;
                attn_item<false>((LAS unsigned char*)lds, QM + tok * 512 + hh * 128, Kg, Kg + 512, 1024, 4, nullptr, 0, 0, 0, OM + tok * 512 + hh * 128);
            }
        }
#endif
    }
    xcd_barrier(bar);
    { pg8::Gemm g{OM, Wo_t, M, 1024, 512}; pg8::StaticOrder S; S.init(M, 1024, G, bid); pg8::EpiBf E{MIX, 1024, 1.f}; GEMM_CALL(g, S, E); }
    xcd_barrier(bar);
    for (int m = gw; m < M; m += NGW) res_norm_row(out + (size_t)m * DM, MIX + (size_t)m * DM, g_mem_post, out + (size_t)m * DM, g_ffn_pre, H + (size_t)m * DM, lane);
    xcd_barrier(bar);
    { pg8::Gemm g{H, Wgu_t, M, 2 * DFF, 1024}; pg8::StaticOrder S; S.init(M, 2 * DFF, G, bid); pg8::EpiSwiglu E{ACT}; GEMM_CALL(g, S, E); }
    xcd_barrier(bar);
    { pg8::Gemm g{ACT, Wdn_t, M, 1024, DFF}; pg8::StaticOrder S; S.init(M, 1024, G, bid); pg8::EpiBf E{MIX, 1024, 1.f}; GEMM_CALL(g, S, E); }
    xcd_barrier(bar);
    for (int m = gw; m < M; m += NGW) res_norm_row(out + (size_t)m * DM, MIX + (size_t)m * DM, g_ffn_post, out + (size_t)m * DM, nullptr, nullptr, lane);
}

extern "C" void kernel_launch(void* const* d_in, const int* in_sizes, int n_in, void* d_out, int out_size, void* d_ws, size_t ws_size, hipStream_t stream) {
    static int grid = 0;
    if (grid == 0) {
        if (n_in != 21 || in_sizes[0] != M * DM || out_size != M * DM || ws_size < WS_END) { fprintf(stderr, "kernel_launch: unexpected shapes (n_in %d, in0 %d, out %d, ws %zu)\n", n_in, n_in > 0 ? in_sizes[0] : -1, out_size, ws_size); grid = -1; return; }
        int dev = 0, cus = 0, per_cu = 0;
        if (hipGetDevice(&dev) != hipSuccess || hipDeviceGetAttribute(&cus, hipDeviceAttributeMultiprocessorCount, dev) != hipSuccess) { grid = -1; return; }
        if (hipFuncSetAttribute((const void*)fwd_kernel, hipFuncAttributeMaxDynamicSharedMemorySize, LDS_BYTES) != hipSuccess) { fprintf(stderr, "kernel_launch: hipFuncSetAttribute failed\n"); grid = -1; return; }
        if (hipOccupancyMaxActiveBlocksPerMultiprocessor(&per_cu, (const void*)fwd_kernel, NTHR, LDS_BYTES) != hipSuccess || per_cu < 1) { fprintf(stderr, "kernel_launch: occupancy query says %d blocks per CU\n", per_cu); }
        (void)hipGetLastError();
        grid = cus;
    }
    if (grid < 0) return;
    (void)hipMemsetAsync((char*)d_ws + WS_CTL, 0, CTL_ZERO_BYTES, stream);
    Args a{};
    for (int i = 0; i < 21; ++i) a.in[i] = (const float*)d_in[i];
    a.out = (float*)d_out; a.ws = (unsigned char*)d_ws;
    hipLaunchKernelGGL(fwd_kernel, dim3(grid), dim3(NTHR), LDS_BYTES, stream, a);
}
```

```cpp
#include <hip/hip_runtime.h>
#include <cstdio>
#include <cstdint>

#define LAS __attribute__((address_space(3)))
typedef unsigned short bf16_t;
typedef short bf16x8 __attribute__((ext_vector_type(8)));
typedef float f32x4 __attribute__((ext_vector_type(4)));
typedef float f32x2 __attribute__((ext_vector_type(2)));
typedef unsigned u32x4 __attribute__((ext_vector_type(4)));
typedef unsigned u32x2 __attribute__((ext_vector_type(2)));
typedef __bf16 bf16x2_t __attribute__((ext_vector_type(2)));

constexpr int NWAVES = 8, NTHR = 512;
constexpr int BATCH = 8, SEQ = 4096, DM = 1024, M = BATCH * SEQ;
constexpr int NMEM = 256, MMEM = BATCH * NMEM;
constexpr int DFF = 2816;
constexpr int IN_W = 4164, IN_PAD = 4352;
constexpr float EPS = 1e-6f;

constexpr size_t MiB = 1u << 20;
constexpr size_t WS_CTL = 0, CTL_ZERO_BYTES = 64 * 1024;
constexpr size_t WS_WIN = 1 * MiB;
constexpr size_t WS_WEFF = 10 * MiB;
constexpr size_t WS_WPA = 11 * MiB;
constexpr size_t WS_WOUT = 13 * MiB;
constexpr size_t WS_WQ = 15 * MiB;
constexpr size_t WS_WKV = 16 * MiB;
constexpr size_t WS_WO = 18 * MiB;
constexpr size_t WS_WGU = 19 * MiB;
constexpr size_t WS_WDN = 30 * MiB;
constexpr size_t WS_MEMN = 36 * MiB;
constexpr size_t WS_KVM = 40 * MiB;
constexpr size_t WS_BM = 44 * MiB;
constexpr size_t WS_H = 64 * MiB;
constexpr size_t WS_U = 128 * MiB;
constexpr size_t WS_Q = 160 * MiB;
constexpr size_t WS_KV = 224 * MiB;
constexpr size_t WS_QI = 496 * MiB;
constexpr size_t WS_KX = 60 * MiB;
constexpr size_t WS_WI = 512 * 1024;
constexpr size_t WS_S = 128 * MiB;
constexpr size_t WS_GP = 272 * MiB;
constexpr size_t WS_GA = 336 * MiB;
constexpr size_t WS_PL = 400 * MiB;
constexpr size_t WS_AB = 432 * MiB;
constexpr size_t WS_MG = 128 * MiB;
constexpr size_t WS_MIX = 192 * MiB;
constexpr size_t WS_QM = 256 * MiB;
constexpr size_t WS_OM = 288 * MiB;
constexpr size_t WS_ACT = 320 * MiB;
constexpr size_t WS_END = 512 * MiB;

constexpr int CW_BAR = 1024;

constexpr int RING_BYTES = 131072;
constexpr int LDSCTL_OFF = RING_BYTES, MISC_OFF = LDSCTL_OFF + 320;
constexpr int LDS_BYTES = 147456;

__device__ __forceinline__ unsigned cvtpk(float lo, float hi) { f32x2 v = {lo, hi}; bf16x2_t b = __builtin_convertvector(v, bf16x2_t); return __builtin_bit_cast(unsigned, b); }
__device__ __forceinline__ bf16_t f2bf(float f) { return (bf16_t)(cvtpk(f, 0.f) & 0xffffu); }
__device__ __forceinline__ float bf2f(bf16_t b) { return __uint_as_float((unsigned)b << 16); }
__device__ __forceinline__ float bflo(unsigned w) { return __uint_as_float(w << 16); }
__device__ __forceinline__ float bfhi(unsigned w) { return __uint_as_float(w & 0xffff0000u); }
__device__ __forceinline__ float wave_sum(float v) {
#pragma unroll
    for (int o = 1; o < 64; o <<= 1) v += __shfl_xor(v, o);
    return v;
}
__device__ __forceinline__ float wave_max(float v) {
#pragma unroll
    for (int o = 1; o < 64; o <<= 1) v = fmaxf(v, __shfl_xor(v, o));
    return v;
}
__device__ __forceinline__ unsigned fkey(float f) { const unsigned b = __float_as_uint(f); return (b & 0x80000000u) ? ~b : (b | 0x80000000u); }
__device__ __forceinline__ float sigmoidf_(float x) { return 1.f / (1.f + __expf(-x)); }

#define XB_TMO      128
#define XB_XCNT(j)  (256  + 64 * (j))
#define XB_XSUB(j)  (1280 + 64 * (j))
#define XB_XGEN(j)  (2304 + 64 * (j))
#define XB_TOP      3328
#define XB_TOPGEN   3392
#define XCD_BAR_WORDS 3456
#define XB_SPIN_CAP (1u << 22)

__device__ __forceinline__ unsigned xb_ld(unsigned* p)              { return __hip_atomic_load(p, __ATOMIC_RELAXED, __HIP_MEMORY_SCOPE_AGENT); }
__device__ __forceinline__ unsigned xb_add(unsigned* p, unsigned v) { return __hip_atomic_fetch_add(p, v, __ATOMIC_RELAXED, __HIP_MEMORY_SCOPE_AGENT); }
__device__ __forceinline__ unsigned xb_xcc_id() { return (unsigned)__builtin_amdgcn_s_getreg((3 << 11) | 20) & 0xFu; }
#define XB_SPIN(cond, bar) do { unsigned _sp = 0; while (cond) { __builtin_amdgcn_s_sleep(1); \
    if ((++_sp & 255u) == 0u) { if (xb_ld(&(bar)[XB_TMO])) break; if (_sp > XB_SPIN_CAP) { atomicAdd(&(bar)[XB_TMO], 1u); break; } } } } while (0)

struct XcdBarrier { unsigned* bar; unsigned x; volatile LAS unsigned* st; };

__device__ __forceinline__ XcdBarrier xcd_barrier_post(unsigned* bar, volatile LAS unsigned* st) {
    XcdBarrier b; b.bar = bar; b.x = xb_xcc_id(); b.st = st;
    if (threadIdx.x == 0) (void)xb_add(&bar[XB_XCNT(b.x)], 1u);
    return b;
}
__device__ __forceinline__ void xcd_barrier_complete(unsigned* bar, unsigned x, unsigned& nloc, unsigned& nx) {
    const unsigned G = gridDim.x * gridDim.y * gridDim.z;
    unsigned sum, cnt, mine, sp = 0u;
    for (;;) {
        sum = 0u; cnt = 0u; mine = 0u;
#pragma unroll
        for (unsigned j = 0; j < 16; ++j) { const unsigned c = xb_ld(&bar[XB_XCNT(j)]); sum += c; cnt += (c > 0u) ? 1u : 0u; mine = (j == x) ? c : mine; }
        if (sum == G) break;
        __builtin_amdgcn_s_sleep(1);
        if ((++sp & 255u) == 0u) { if (xb_ld(&bar[XB_TMO])) break; if (sp > XB_SPIN_CAP) { atomicAdd(&bar[XB_TMO], 1u); break; } }
    }
    nloc = mine > 0u ? mine : 1u; nx = cnt > 0u ? cnt : 1u;
}
__device__ __forceinline__ void xcd_barrier(const XcdBarrier& b) {
    asm volatile("s_waitcnt vmcnt(0)" ::: "memory");
    __syncthreads();
    if (threadIdx.x == 0) {
        unsigned* bar = b.bar;
        __builtin_amdgcn_s_waitcnt(0);
        unsigned nloc = b.st[0], nx = b.st[1];
        if (nloc == 0u) { xcd_barrier_complete(bar, b.x, nloc, nx); b.st[0] = nloc; b.st[1] = nx; }
        const unsigned old = xb_add(&bar[XB_XSUB(b.x)], 1u);
        const unsigned gen = old / nloc;
        if (old + 1u == (gen + 1u) * nloc) {
            __builtin_amdgcn_fence(__ATOMIC_RELEASE, "agent");
            asm volatile("s_waitcnt vmcnt(0)" ::: "memory");
            const unsigned og = xb_add(&bar[XB_TOP], 1u);
            const unsigned tg = og / nx;
            if (og + 1u == (tg + 1u) * nx) xb_add(&bar[XB_TOPGEN], 1u);
            else XB_SPIN(xb_ld(&bar[XB_TOPGEN]) == tg, bar);
            __builtin_amdgcn_fence(__ATOMIC_ACQUIRE, "agent");
            xb_add(&bar[XB_XGEN(b.x)], 1u);
            asm volatile("s_waitcnt vmcnt(0)" ::: "memory");
        } else {
            XB_SPIN(xb_ld(&bar[XB_XGEN(b.x)]) == gen, bar);
            __builtin_amdgcn_fence(__ATOMIC_ACQUIRE, "agent");
            asm volatile("s_waitcnt vmcnt(0)" ::: "memory");
        }
    }
    __syncthreads();
}

namespace pg8 {
constexpr int BM = 256, HALF = 128, NXCD = 8, WGM = 8;
struct Unit { int pm, pn; };
struct Gemm { const bf16_t* A; const bf16_t* Bt; int M, N, K; };
struct StaticOrder {
    int nM, nN, nwg, G, c;
    __device__ void init(int M_, int N_, int G_, int c_) { nM = M_ / BM; nN = N_ / BM; nwg = nM * nN; G = G_; c = c_; }
    __device__ bool next(int i, Unit& u) const {
        const long L = (long)i * G + c; if (L >= nwg) return false;
        int wgid = (int)L; { const int q = nwg / NXCD, r = nwg % NXCD, xcd = wgid % NXCD, off = wgid / NXCD; wgid = (xcd < r ? xcd * (q + 1) : r * (q + 1) + (xcd - r) * q) + off; }
        const int nig = WGM * nN, gid = wgid / nig, fm = gid * WGM, gsz = (nM - fm) < WGM ? (nM - fm) : WGM;
        u.pm = fm + ((wgid % nig) % gsz); u.pn = (wgid % nig) / gsz; return true;
    }
    __device__ __forceinline__ void a_ready(const Unit&) const {}
    __device__ __forceinline__ void done(const Unit&) const {}
};
template <class Epi>
__device__ __forceinline__ void gemm_simple(const Gemm g, const StaticOrder& S, const Epi& E) {
    const int tid = threadIdx.x, wid = __builtin_amdgcn_readfirstlane(tid >> 6), lane = tid & 63, wr = wid >> 2, wc = wid & 3, fr = lane & 15, fq = lane >> 4;
    const int K = g.K;
    Unit u;
    for (int i = 0; S.next(i, u); ++i) {
        f32x4 acc[2][2][4][2];
#pragma unroll
        for (int a = 0; a < 2; ++a)
#pragma unroll
            for (int b = 0; b < 2; ++b)
#pragma unroll
                for (int m = 0; m < 4; ++m)
#pragma unroll
                    for (int n = 0; n < 2; ++n) acc[a][b][m][n] = (f32x4){0.f, 0.f, 0.f, 0.f};
        const bf16_t* Ab = g.A + (size_t)(u.pm * BM + wr * 64 + fr) * K + fq * 8;
        const bf16_t* Bb = g.Bt + (size_t)(u.pn * BM + wc * 32 + fr) * K + fq * 8;
        for (int kk = 0; kk < K; kk += 32) {
            bf16x8 Bf[2][2];
#pragma unroll
            for (int b = 0; b < 2; ++b)
#pragma unroll
                for (int n = 0; n < 2; ++n) Bf[b][n] = *(const bf16x8*)(Bb + (size_t)(b * HALF + n * 16) * K + kk);
#pragma unroll
            for (int a = 0; a < 2; ++a) {
                bf16x8 At[4];
#pragma unroll
                for (int m = 0; m < 4; ++m) At[m] = *(const bf16x8*)(Ab + (size_t)(a * HALF + m * 16) * K + kk);
#pragma unroll
                for (int b = 0; b < 2; ++b)
#pragma unroll
                    for (int m = 0; m < 4; ++m)
#pragma unroll
                        for (int n = 0; n < 2; ++n) acc[a][b][m][n] = __builtin_amdgcn_mfma_f32_16x16x32_bf16(Bf[b][n], At[m], acc[a][b][m][n], 0, 0, 0);
            }
        }
        E(acc, u, wr, wc, fr, fq);
    }
}
#define PG8_LAS __attribute__((address_space(3)))
constexpr int BK = 64, HTB = HALF * BK * 2, STAGE_BYTES = 8 * HTB;
__host__ __device__ __forceinline__ int lds_byte(int r, int c) { const int st = (r >> 4) * 2 + (c >> 5), rr = r & 15, cc = c & 31, ob = rr * 64 + cc * 2; return st * 1024 + (ob ^ (((ob >> 9) & 1) << 5)); }
__host__ __device__ __forceinline__ void stage_rc(int b, int& R, int& C) { const int st = b / 1024, sb = b % 1024, swz = sb ^ (((sb >> 9) & 1) << 5); R = (st >> 1) * 16 + swz / 64; C = (st & 1) * 32 + (swz % 64) / 2; }
__host__ __device__ __forceinline__ int perm32(int rho) { const int n = rho >> 4, i = rho & 15; return 8 * (i >> 2) + 4 * n + (i & 3); }
template <class Epi, class Sched, bool ALIGN_EPI = false, bool SP2 = false>
__device__ __forceinline__ void gemm_phase(PG8_LAS unsigned char* lds, const Gemm g, const Sched& S, const Epi& E) {
    const int tid = threadIdx.x, wid = __builtin_amdgcn_readfirstlane(tid >> 6), lane = tid & 63, wr = wid >> 2, wc = wid & 3, fr = lane & 15, fq = lane >> 4;
    const int K = g.K, nt = K / BK;
    unsigned voffA[2], voffB[2];
#pragma unroll
    for (int i = 0; i < 2; ++i) { int R, C; stage_rc(tid * 16 + i * 8192, R, C); const int Rb = Epi::PERM ? ((R & ~31) + perm32(R & 31)) : R;
        voffA[i] = (unsigned)(R * K + C) * 2u; voffB[i] = (unsigned)(Rb * K + C) * 2u; }
    const size_t kstep = (size_t)(BK * 2);
    const size_t hstep = (size_t)HALF * K * 2;
    const size_t tstep = 2 * hstep;
    const unsigned ldsw = (unsigned)wid * 1024u;
    const int aoff = lds_byte(wr * 64 + fr, fq * 8), boff = lds_byte(wc * 32 + fr, fq * 8);
#define PG8_SA(b, h) (((b) * 2 + (h)) * HTB)
#define PG8_SB(b, h) ((4 + (b) * 2 + (h)) * HTB)
#define PG8_STAGE(bufoff, gbase, voff) do { _Pragma("unroll") for (int _i = 0; _i < 2; ++_i) \
        __builtin_amdgcn_global_load_lds((const unsigned*)((const char*)(gbase) + (voff)[_i]), (PG8_LAS unsigned*)(lds + (bufoff) + ldsw + _i * 8192), 16, 0, 0); } while (0)
#define PG8_LDA(dst, b, h) do { _Pragma("unroll") for (int m = 0; m < 4; ++m) _Pragma("unroll") for (int k = 0; k < 2; ++k) dst[m][k] = *(const PG8_LAS bf16x8*)(lds + PG8_SA(b, h) + aoff + m * 2048 + k * 1024); } while (0)
#define PG8_LDB(dst, b, h) do { _Pragma("unroll") for (int n = 0; n < 2; ++n) _Pragma("unroll") for (int k = 0; k < 2; ++k) dst[n][k] = *(const PG8_LAS bf16x8*)(lds + PG8_SB(b, h) + boff + n * 2048 + k * 1024); } while (0)
#define PG8_MMA(ai, bj, At, Bt) do { __builtin_amdgcn_s_setprio(1); _Pragma("unroll") for (int m = 0; m < 4; ++m) _Pragma("unroll") for (int n = 0; n < 2; ++n) _Pragma("unroll") for (int k = 0; k < 2; ++k) \
        acc[ai][bj][m][n] = __builtin_amdgcn_mfma_f32_16x16x32_bf16(Bt[n][k], At[m][k], acc[ai][bj][m][n], 0, 0, 0); __builtin_amdgcn_s_setprio(0); } while (0)
#define PG8_WAIT_V(n) asm volatile("s_waitcnt vmcnt(" #n ")" ::: "memory")
#define PG8_WAIT_L(n) asm volatile("s_waitcnt lgkmcnt(" #n ")" ::: "memory")
#define PG8_BAR __builtin_amdgcn_s_barrier()
#define PG8_SCHED __builtin_amdgcn_sched_barrier(0)
    Unit cur, nxt; int ui = 0;
    if (!S.next(0, cur)) return;
    f32x4 acc[2][2][4][2];
#pragma unroll
    for (int a = 0; a < 2; ++a)
#pragma unroll
        for (int b = 0; b < 2; ++b)
#pragma unroll
            for (int m = 0; m < 4; ++m)
#pragma unroll
                for (int n = 0; n < 2; ++n) acc[a][b][m][n] = (f32x4){0.f, 0.f, 0.f, 0.f};
    bf16x8 At[4][2], B0[2][2], B1[2][2];
    const char* cA = (const char*)g.A + (size_t)cur.pm * tstep; const char* cB = (const char*)g.Bt + (size_t)cur.pn * tstep;
    S.a_ready(cur);
    if constexpr (SP2) {
        PG8_STAGE(PG8_SB(0, 0), cB, voffB); PG8_STAGE(PG8_SB(0, 1), cB + hstep, voffB); PG8_STAGE(PG8_SA(0, 0), cA, voffA); PG8_STAGE(PG8_SA(0, 1), cA + hstep, voffA);
        if (wr == 1) PG8_BAR;
        PG8_WAIT_V(2); PG8_BAR;
        PG8_STAGE(PG8_SB(1, 0), cB + kstep, voffB); PG8_STAGE(PG8_SA(1, 0), cA + kstep, voffA); PG8_STAGE(PG8_SB(1, 1), cB + hstep + kstep, voffB);
        PG8_WAIT_V(6); PG8_BAR;
    } else {
        PG8_STAGE(PG8_SB(0, 0), cB, voffB); PG8_STAGE(PG8_SA(0, 0), cA, voffA); PG8_STAGE(PG8_SB(0, 1), cB + hstep, voffB); PG8_STAGE(PG8_SA(0, 1), cA + hstep, voffA);
        if (wr == 1) PG8_BAR;
        PG8_WAIT_V(4); PG8_BAR;
        PG8_STAGE(PG8_SB(1, 0), cB + kstep, voffB); PG8_STAGE(PG8_SA(1, 0), cA + kstep, voffA); PG8_STAGE(PG8_SB(1, 1), cB + hstep + kstep, voffB);
        PG8_WAIT_V(6); PG8_BAR;
    }
    for (;;) {
        const bool has_next = S.next(ui + 1, nxt);
        const char* nA = has_next ? (const char*)g.A + (size_t)nxt.pm * tstep : cA; const char* nB = has_next ? (const char*)g.Bt + (size_t)nxt.pn * tstep : cB;
        for (int t = 0; t < nt; t += 2) {
            const bool last = (t == nt - 2);
            const char* a1 = cA + (size_t)(t + 1) * kstep;
            const char* a2 = last ? nA : cA + (size_t)(t + 2) * kstep; const char* b2 = last ? nB : cB + (size_t)(t + 2) * kstep;
            const char* a3 = a2 + kstep; const char* b3 = b2 + kstep;
            if (last && has_next) S.a_ready(nxt);
            if constexpr (SP2) {
            PG8_LDB(B0, 0, 0); PG8_LDB(B1, 0, 1); PG8_SCHED; PG8_LDA(At, 0, 0); PG8_STAGE(PG8_SA(1, 1), a1 + hstep, voffA);
            PG8_WAIT_V(8); PG8_WAIT_L(0); PG8_BAR; PG8_MMA(0, 0, At, B0); PG8_MMA(0, 1, At, B1); PG8_BAR; PG8_SCHED;
            PG8_LDA(At, 0, 1); PG8_STAGE(PG8_SB(0, 0), b2, voffB); PG8_STAGE(PG8_SB(0, 1), b2 + hstep, voffB); PG8_STAGE(PG8_SA(0, 0), a2, voffA);
            PG8_WAIT_V(8); PG8_WAIT_L(0); PG8_BAR; PG8_MMA(1, 0, At, B0); PG8_MMA(1, 1, At, B1); PG8_BAR; PG8_SCHED;
            PG8_LDB(B0, 1, 0); PG8_LDB(B1, 1, 1); PG8_SCHED; PG8_LDA(At, 1, 0); PG8_STAGE(PG8_SA(0, 1), a2 + hstep, voffA);
            PG8_WAIT_V(8); PG8_WAIT_L(0); PG8_BAR; PG8_MMA(0, 0, At, B0); PG8_MMA(0, 1, At, B1); PG8_BAR; PG8_SCHED;
            PG8_LDA(At, 1, 1); PG8_STAGE(PG8_SB(1, 0), b3, voffB); PG8_STAGE(PG8_SB(1, 1), b3 + hstep, voffB); PG8_STAGE(PG8_SA(1, 0), a3, voffA);
            PG8_WAIT_V(8); PG8_WAIT_L(0); PG8_BAR; PG8_MMA(1, 0, At, B0); PG8_MMA(1, 1, At, B1); PG8_BAR; PG8_SCHED;
            } else {
            PG8_LDB(B0, 0, 0); PG8_SCHED; PG8_LDA(At, 0, 0); PG8_STAGE(PG8_SA(1, 1), a1 + hstep, voffA);
            PG8_WAIT_L(8); PG8_BAR; PG8_WAIT_L(0); PG8_MMA(0, 0, At, B0); PG8_BAR; PG8_SCHED;
            PG8_LDB(B1, 0, 1); PG8_STAGE(PG8_SB(0, 0), b2, voffB);
            PG8_BAR; PG8_WAIT_L(0); PG8_MMA(0, 1, At, B1); PG8_BAR;
            PG8_LDA(At, 0, 1); PG8_STAGE(PG8_SA(0, 0), a2, voffA);
            PG8_BAR; PG8_WAIT_L(0); PG8_MMA(1, 0, At, B0); PG8_BAR; PG8_SCHED;
            PG8_STAGE(PG8_SB(0, 1), b2 + hstep, voffB);
            PG8_WAIT_V(6); PG8_BAR; PG8_MMA(1, 1, At, B1); PG8_BAR;
            PG8_LDB(B0, 1, 0); PG8_SCHED; PG8_LDA(At, 1, 0); PG8_STAGE(PG8_SA(0, 1), a2 + hstep, voffA);
            PG8_WAIT_L(8); PG8_BAR; PG8_WAIT_L(0); PG8_MMA(0, 0, At, B0); PG8_BAR; PG8_SCHED;
            PG8_LDB(B1, 1, 1); PG8_STAGE(PG8_SB(1, 0), b3, voffB);
            PG8_BAR; PG8_WAIT_L(0); PG8_MMA(0, 1, At, B1); PG8_BAR;
            PG8_LDA(At, 1, 1); PG8_STAGE(PG8_SA(1, 0), a3, voffA);
            PG8_BAR; PG8_WAIT_L(0); PG8_MMA(1, 0, At, B0); PG8_BAR; PG8_SCHED;
            PG8_STAGE(PG8_SB(1, 1), b3 + hstep, voffB);
            PG8_WAIT_V(6); PG8_BAR; PG8_MMA(1, 1, At, B1); PG8_BAR;
            }
        }
        if constexpr (ALIGN_EPI) { if (wr == 0) PG8_BAR; }
        if constexpr (!Epi::AFTER_DRAIN) { E(acc, cur, wr, wc, fr, fq); S.done(cur); }
        if (!has_next) break;
#pragma unroll
        for (int a = 0; a < 2; ++a)
#pragma unroll
            for (int b = 0; b < 2; ++b)
#pragma unroll
                for (int m = 0; m < 4; ++m)
#pragma unroll
                    for (int n = 0; n < 2; ++n) acc[a][b][m][n] = (f32x4){0.f, 0.f, 0.f, 0.f};
        cur = nxt; cA = nA; cB = nB; ++ui;
        if constexpr (ALIGN_EPI) { if (wr == 1) PG8_BAR; }
    }
    PG8_WAIT_V(0);
    if constexpr (!ALIGN_EPI) { if (wr == 0) PG8_BAR; }
    PG8_BAR;
    if constexpr (Epi::AFTER_DRAIN) { E.fused(acc, cur, wr, wc, fr, fq, lds, wid, lane); S.done(cur); }
#undef PG8_SA
#undef PG8_SB
#undef PG8_STAGE
#undef PG8_LDA
#undef PG8_LDB
#undef PG8_MMA
#undef PG8_WAIT_V
#undef PG8_WAIT_L
#undef PG8_BAR
#undef PG8_SCHED
}
__device__ __forceinline__ void st_bf16x4(bf16_t* p, f32x4 v) { u32x2 w; w.x = cvtpk(v[0], v[1]); w.y = cvtpk(v[2], v[3]); *(u32x2*)p = w; }

struct EpiBf {
    static constexpr bool PERM = false, AFTER_DRAIN = false;
    bf16_t* O; int ldc; float scale;
    __device__ __forceinline__ void operator()(const f32x4 (&acc)[2][2][4][2], const Unit& u, int wr, int wc, int fr, int fq) const {
#pragma unroll
        for (int ai = 0; ai < 2; ++ai)
#pragma unroll
            for (int m = 0; m < 4; ++m) {
                const size_t row = (size_t)(u.pm * BM + ai * HALF + wr * 64 + m * 16 + fr);
#pragma unroll
                for (int bj = 0; bj < 2; ++bj)
#pragma unroll
                    for (int n = 0; n < 2; ++n) st_bf16x4(O + row * ldc + u.pn * BM + bj * HALF + wc * 32 + n * 16 + 4 * fq, acc[ai][bj][m][n] * scale);
            }
    }
};
struct EpiP1 {
    static constexpr bool PERM = false, AFTER_DRAIN = false;
    bf16_t *U, *Q, *KV, *QI, *KX, *WI, *GP, *GA; int pn0;
    __device__ __forceinline__ void operator()(const f32x4 (&acc)[2][2][4][2], const Unit& u, int wr, int wc, int fr, int fq) const {
        const int pn = u.pn + pn0; bf16_t* base; int ldc, c0; float sc = 1.f;
        if (pn == 8) {
#pragma unroll
            for (int ai = 0; ai < 2; ++ai)
#pragma unroll
                for (int m = 0; m < 4; ++m) {
                    const size_t row = (size_t)(u.pm * BM + ai * HALF + wr * 64 + m * 16 + fr);
                    if (wc < 2) {
#pragma unroll
                        for (int n = 0; n < 2; ++n) st_bf16x4(KX + (((row >> 5) * 4 + (2 * wc + n)) * 512 + ((fq >> 1) * 32 + (row & 31)) * 8 + 4 * (fq & 1)), acc[ai][0][m][n]);
                    } else if (wc == 2 && fq == 0) st_bf16x4(WI + row * 4, acc[ai][0][m][0]);
                }
            return;
        }
        if (pn < 2) { base = U; ldc = 512; c0 = pn * 256; }
        else if (pn < 6) { base = Q; ldc = 1024; c0 = (pn - 2) * 256; sc = 0.08838834764831845f * 1.4426950408889634f; }
        else if (pn == 6) { base = KV; ldc = 256; c0 = 0; }
        else if (pn == 7) { base = QI; ldc = 256; c0 = 0; }
        else if (pn < 13) { base = GP; ldc = 1024; c0 = (pn - 9) * 256; }
        else { base = GA; ldc = 1024; c0 = (pn - 13) * 256; }
#pragma unroll
        for (int ai = 0; ai < 2; ++ai)
#pragma unroll
            for (int m = 0; m < 4; ++m) {
                const size_t row = (size_t)(u.pm * BM + ai * HALF + wr * 64 + m * 16 + fr);
#pragma unroll
                for (int bj = 0; bj < 2; ++bj)
#pragma unroll
                    for (int n = 0; n < 2; ++n) st_bf16x4(base + row * ldc + c0 + bj * HALF + wc * 32 + n * 16 + 4 * fq, acc[ai][bj][m][n] * sc);
            }
    }
};
struct EpiMerge {
    static constexpr bool PERM = false, AFTER_DRAIN = false;
    const bf16_t *AB, *GP, *GA; bf16_t* MG;
    __device__ __forceinline__ void operator()(const f32x4 (&acc)[2][2][4][2], const Unit& u, int wr, int wc, int fr, int fq) const {
#pragma unroll
        for (int ai = 0; ai < 2; ++ai)
#pragma unroll
            for (int m = 0; m < 4; ++m) {
                const size_t row = (size_t)(u.pm * BM + ai * HALF + wr * 64 + m * 16 + fr);
#pragma unroll
                for (int bj = 0; bj < 2; ++bj)
#pragma unroll
                    for (int n = 0; n < 2; ++n) {
                        const size_t off = row * 1024 + u.pn * BM + bj * HALF + wc * 32 + n * 16 + 4 * fq;
                        const u32x2 a = *(const u32x2*)(AB + off), gp = *(const u32x2*)(GP + off), ga = *(const u32x2*)(GA + off);
                        const f32x4 b = acc[ai][bj][m][n]; f32x4 o;
                        o[0] = sigmoidf_(bflo(gp.x)) * bflo(a.x) + sigmoidf_(bflo(ga.x)) * b[0];
                        o[1] = sigmoidf_(bfhi(gp.x)) * bfhi(a.x) + sigmoidf_(bfhi(ga.x)) * b[1];
                        o[2] = sigmoidf_(bflo(gp.y)) * bflo(a.y) + sigmoidf_(bflo(ga.y)) * b[2];
                        o[3] = sigmoidf_(bfhi(gp.y)) * bfhi(a.y) + sigmoidf_(bfhi(ga.y)) * b[3];
                        st_bf16x4(MG + off, o);
                    }
            }
    }
};
struct EpiSwiglu {
    static constexpr bool PERM = false, AFTER_DRAIN = false;
    bf16_t* ACT;
    __device__ __forceinline__ void operator()(const f32x4 (&acc)[2][2][4][2], const Unit& u, int wr, int wc, int fr, int fq) const {
#pragma unroll
        for (int ai = 0; ai < 2; ++ai)
#pragma unroll
            for (int m = 0; m < 4; ++m) {
                const size_t row = (size_t)(u.pm * BM + ai * HALF + wr * 64 + m * 16 + fr);
#pragma unroll
                for (int n = 0; n < 2; ++n) {
                    const f32x4 gt = acc[ai][0][m][n], up = acc[ai][1][m][n]; f32x4 o;
#pragma unroll
                    for (int i = 0; i < 4; ++i) o[i] = gt[i] * sigmoidf_(gt[i]) * up[i];
                    st_bf16x4(ACT + row * DFF + u.pn * HALF + wc * 32 + n * 16 + 4 * fq, o);
                }
            }
    }
};
}


#ifndef TS_ENABLE
#define TS_ENABLE 0
#endif
#ifndef TS_A
#define TS_A 0
#endif
#ifndef TS_B
#define TS_B 0
#endif
typedef float f32x16 __attribute__((ext_vector_type(16)));
typedef short s16x4 __attribute__((ext_vector_type(4)));
constexpr float C2Q = 0.08838834764831845f * 1.4426950408889634f;
constexpr float LOG2E = 1.4426950408889634f;

constexpr size_t S_BSTR = 64ull * 65 * 2048;
__device__ __forceinline__ size_t s_row_off(int t) { const int Q = t >> 6, r = t & 63; return (size_t)(64 * (Q + 1)) * (size_t)(32 * Q + r); }
__device__ __forceinline__ void index_score_phase(const bf16_t* QI, const bf16_t* KX, const bf16_t* WI, unsigned* S, int bid, int G) {
    const int tid = threadIdx.x, lane = tid & 63, wave = __builtin_amdgcn_readfirstlane(tid >> 6), r = lane & 31, h = lane >> 5;
    for (int j = bid; j < 2048; j += G) {
#pragma unroll 1
      for (int e = 0; e < 2; ++e) {
        const int b = j >> 8, tt = e == 0 ? (j & 255) : 511 - (j & 255);
        const int t0 = tt * 8, tok0 = b * SEQ + t0, ng = 2 * ((t0 >> 6) + 1);
        if (wave >= ng) continue;
        bf16x8 aq[4];
#pragma unroll
        for (int s = 0; s < 4; ++s) aq[s] = *(const bf16x8*)(QI + (size_t)(tok0 + (r >> 2)) * 256 + (r & 3) * 64 + 16 * s + 8 * h);
        float wv[4][4], bnd[4][4];
        unsigned* srow[4];
#pragma unroll
        for (int g = 0; g < 4; ++g) { const u32x2 ww = *(const u32x2*)(WI + (size_t)(tok0 + 2 * g + h) * 4);
            wv[g][0] = bflo(ww.x) * 0.0625f; wv[g][1] = bfhi(ww.x) * 0.0625f; wv[g][2] = bflo(ww.y) * 0.0625f; wv[g][3] = bfhi(ww.y) * 0.0625f;
#pragma unroll
            for (int q = 0; q < 4; ++q) bnd[g][q] = wv[g][q] > 0.f ? INFINITY : -INFINITY;
            srow[g] = S + (size_t)b * S_BSTR + s_row_off(t0 + 2 * g + h) + r; }
        const bf16_t* kbase = KX + (size_t)b * (SEQ / 32) * 2048 + lane * 8;
        bf16x8 kb[4], kn[4];
#pragma unroll
        for (int s = 0; s < 4; ++s) kb[s] = *(const bf16x8*)(kbase + (size_t)wave * 2048 + s * 512);
#pragma unroll 1
        for (int gi = wave; gi < ng; gi += 8) {
            const int gn = gi + 8 < ng ? gi + 8 : gi;
#pragma unroll
            for (int s = 0; s < 4; ++s) kn[s] = *(const bf16x8*)(kbase + (size_t)gn * 2048 + s * 512);
            f32x16 c = {};
#pragma unroll
            for (int s = 0; s < 4; ++s) c = __builtin_amdgcn_mfma_f32_32x32x16_bf16(aq[s], kb[s], c, 0, 0, 0);
            const int key = 32 * gi + r;
#pragma unroll
            for (int g = 0; g < 4; ++g) {
                float sc = __builtin_amdgcn_fmed3f(c[4 * g] * wv[g][0], 0.f, bnd[g][0]) + __builtin_amdgcn_fmed3f(c[4 * g + 1] * wv[g][1], 0.f, bnd[g][1])
                         + __builtin_amdgcn_fmed3f(c[4 * g + 2] * wv[g][2], 0.f, bnd[g][2]) + __builtin_amdgcn_fmed3f(c[4 * g + 3] * wv[g][3], 0.f, bnd[g][3]);
                sc += 0.0f;
                srow[g][32 * gi] = (key <= t0 + 2 * g + h) ? fkey(sc) : 0u;
            }
#pragma unroll
            for (int s = 0; s < 4; ++s) kb[s] = kn[s];
        }
      }
    }
}
__device__ __forceinline__ unsigned wave_incl_scan(unsigned v) {
    v += __builtin_amdgcn_update_dpp(0u, v, 0x111, 0xf, 0xf, false);
    v += __builtin_amdgcn_update_dpp(0u, v, 0x112, 0xf, 0xf, false);
    v += __builtin_amdgcn_update_dpp(0u, v, 0x114, 0xf, 0xf, false);
    v += __builtin_amdgcn_update_dpp(0u, v, 0x118, 0xf, 0xf, false);
    v += __builtin_amdgcn_update_dpp(0u, v, 0x142, 0xa, 0xf, false);
    v += __builtin_amdgcn_update_dpp(0u, v, 0x143, 0xc, 0xf, false);
    return v;
}
__device__ __forceinline__ void hist_select(unsigned* hist, int lane, unsigned need, unsigned& dig, unsigned& rem, unsigned& ce) {
    unsigned* hb = hist + (2016 - 32 * lane);
    unsigned tot = 0u;
#pragma unroll
    for (int q = 0; q < 8; ++q) { const u32x4 v = *(const u32x4*)(hb + 4 * ((q + lane) & 7)); tot += (v.x + v.y) + (v.z + v.w); }
    const unsigned cum = wave_incl_scan(tot);
    const unsigned long long bal = __ballot(cum >= need);
    const int first = bal ? (__ffsll((long long)bal) - 1) : 63;
    const unsigned rem0 = need - (__builtin_amdgcn_readlane(cum, first) - __builtin_amdgcn_readlane(tot, first));
    const int top = 2047 - 32 * first;
    const unsigned f = lane < 32 ? hist[top - lane] : 0u;
    const unsigned fcum = wave_incl_scan(f);
    const unsigned long long bal2 = __ballot(fcum >= rem0);
    const int q0 = bal2 ? (__ffsll((long long)bal2) - 1) : 31;
    ce = __builtin_amdgcn_readlane(f, q0); rem = rem0 - (__builtin_amdgcn_readlane(fcum, q0) - ce); dig = (unsigned)(top - q0);
#pragma unroll
    for (int q = 0; q < 8; ++q) *(u32x4*)(hb + 4 * ((q + lane) & 7)) = (u32x4){0u, 0u, 0u, 0u};
}
#define WLANE4(lo, hi, b0, b1, b2, b3, i) asm volatile("s_nop 3\n\tv_writelane_b32 %0, %2, %10\n\tv_writelane_b32 %1, %3, %10\n\tv_writelane_b32 %0, %4, %11\n\tv_writelane_b32 %1, %5, %11\n\t" \
    "v_writelane_b32 %0, %6, %12\n\tv_writelane_b32 %1, %7, %12\n\tv_writelane_b32 %0, %8, %13\n\tv_writelane_b32 %1, %9, %13\n\ts_nop 1" : "+v"(lo), "+v"(hi) \
    : "s"((unsigned)(b0)), "s"((unsigned)((b0) >> 32)), "s"((unsigned)(b1)), "s"((unsigned)((b1) >> 32)), "s"((unsigned)(b2)), "s"((unsigned)((b2) >> 32)), "s"((unsigned)(b3)), "s"((unsigned)((b3) >> 32)), \
      "n"(i), "n"((i) + 1), "n"((i) + 2), "n"((i) + 3))
__device__ __forceinline__ void index_select_phase(unsigned char* lds, const unsigned* S, unsigned* BMK, int bid, int G) {
    const int tid = threadIdx.x, lane = tid & 63, wave = __builtin_amdgcn_readfirstlane(tid >> 6);
    unsigned* hist = (unsigned*)(lds + wave * 8192);
    for (int i = lane; i < 2048; i += 64) hist[i] = 0u;
    asm volatile("s_waitcnt lgkmcnt(0)" ::: "memory");
    const int gw = bid * NWAVES + wave, NGW = G * NWAVES;
    for (int j = gw; j < 8 * 2048; j += NGW) {
#pragma unroll 1
      for (int e = 0; e < 2; ++e) {
        const int b = j >> 11, t = e == 0 ? (j & 2047) : 4095 - (j & 2047);
        const int nreg = (t >> 6) + 1;
        const unsigned* srow = S + (size_t)b * S_BSTR + s_row_off(t) + lane;
        unsigned u[64];
#pragma unroll
        for (int i = 0; i < 64; ++i) u[i] = 0u;
#pragma unroll
        for (int k = 0; k < 8; ++k) if (8 * k < nreg) {
#pragma unroll
            for (int ii = 0; ii < 8; ++ii) { const int i = 8 * k + ii; if (i < nreg) u[i] = srow[64 * i]; } }
        unsigned tau = 1u, need = 0u, ceq = 0u;
        if (t >= 256) {
#pragma unroll
            for (int k = 0; k < 8; ++k) if (8 * k < nreg) {
#pragma unroll
                for (int ii = 0; ii < 8; ++ii) { const int i = 8 * k + ii; if (i < nreg) { const unsigned uu = u[i];
                    if (i + 1 < nreg) atomicAdd(hist + (uu >> 21), 1u); else if (uu != 0u) atomicAdd(hist + (uu >> 21), 1u); } } }
            unsigned dig, rem, ce;
            hist_select(hist, lane, 256u, dig, rem, ce);
            tau = dig << 21; need = rem; ceq = ce;
            if (need != ceq) {
#pragma unroll
                for (int k = 0; k < 8; ++k) if (8 * k < nreg) {
#pragma unroll
                    for (int ii = 0; ii < 8; ++ii) { const int i = 8 * k + ii; if (i < nreg) { const unsigned uu = u[i];
                        if ((uu ^ tau) < (1u << 21)) atomicAdd(hist + ((uu >> 10) & 2047u), 1u); } } }
                hist_select(hist, lane, need, dig, rem, ce);
                tau |= dig << 10; need = rem; ceq = ce;
                if (need != ceq) {
#pragma unroll
                    for (int k = 0; k < 8; ++k) if (8 * k < nreg) {
#pragma unroll
                        for (int ii = 0; ii < 8; ++ii) { const int i = 8 * k + ii; if (i < nreg) { const unsigned uu = u[i];
                            if ((uu ^ tau) < (1u << 10)) atomicAdd(hist + (uu & 1023u), 1u); } } }
                    hist_select(hist, lane, need, dig, rem, ce);
                    tau |= dig; need = rem; ceq = ce;
                }
            }
        }
        unsigned outlo = 0u, outhi = 0u;
        if (need == ceq) {
#pragma unroll
            for (int i = 0; i < 64; i += 4) if (i < nreg) {
                const unsigned long long b0 = __ballot(u[i] >= tau), b1 = __ballot(u[i + 1] >= tau), b2 = __ballot(u[i + 2] >= tau), b3 = __ballot(u[i + 3] >= tau);
                WLANE4(outlo, outhi, b0, b1, b2, b3, i); }
        } else {
            unsigned run = 0u;
#pragma unroll
            for (int i = 0; i < 64; i += 4) if (i < nreg) {
                unsigned long long bb[4];
#pragma unroll
                for (int k = 0; k < 4; ++k) { const unsigned uu = u[i + k];
                    const unsigned long long be = __ballot(uu == tau);
                    const unsigned rank = run + __popcll(be & ((1ull << lane) - 1ull)); run += __popcll(be);
                    bb[k] = __ballot((uu > tau) || (uu == tau && rank < need)); }
                WLANE4(outlo, outhi, bb[0], bb[1], bb[2], bb[3], i); }
        }
        if (lane < nreg) *(u32x2*)(BMK + (size_t)(b * SEQ + t) * 128 + 2 * lane) = (u32x2){outlo, outhi};
      }
    }
}

constexpr int KP = 272, VP = 320, KT_BYTES = 64 * KP, VT_BYTES = 64 * VP, ABUF_BYTES = KT_BYTES + VT_BYTES;
constexpr int ATT_LUT_OFF = 2 * ABUF_BYTES;
typedef short v4i16_t __attribute__((ext_vector_type(4)));
__device__ __forceinline__ s16x4 vtr(const LAS unsigned char* p) { return __builtin_bit_cast(s16x4, __builtin_amdgcn_ds_read_tr16_b64_v4i16((LAS v4i16_t*)p)); }

template <bool MASKED>
__device__ __forceinline__ void attn_item(LAS unsigned char* lds, const bf16_t* qrow  , const bf16_t* Kg, const bf16_t* Vg, int kvpitch  ,
                                          int nt, const unsigned* mrow  , int tpos  , int T0, int head, bf16_t* orow) {
    const int tid = threadIdx.x, lane = tid & 63, r = lane & 31, h = lane >> 5;
    bf16x8 qf[8];
#pragma unroll
    for (int s = 0; s < 8; ++s) qf[s] = *(const bf16x8*)(qrow + 16 * s + 8 * h);
    const int srow0 = tid >> 4, scol = tid & 15;
    u32x4 sk[2], sv[2];
#pragma unroll
    for (int i = 0; i < 2; ++i) { sk[i] = *(const u32x4*)(Kg + (size_t)(srow0 + 32 * i) * kvpitch + scol * 8); sv[i] = *(const u32x4*)(Vg + (size_t)(srow0 + 32 * i) * kvpitch + scol * 8); }
#pragma unroll
    for (int i = 0; i < 2; ++i) { *(LAS u32x4*)(lds + (srow0 + 32 * i) * KP + scol * 16) = sk[i]; *(LAS u32x4*)(lds + KT_BYTES + (srow0 + 32 * i) * VP + scol * 16) = sv[i]; }
    __syncthreads();
    f32x16 o[4];
#pragma unroll
    for (int d = 0; d < 4; ++d) o[d] = (f32x16){};
    float mrun = -1e30f, lsum = 0.f;
    const int koff = r * KP + 16 * h;
    const int voff = (4 * h + ((lane & 15) >> 2)) * VP + (((lane >> 4) & 1) * 16 + (lane & 3) * 4) * 2;
    for (int kt = 0; kt < nt; ++kt) {
        LAS unsigned char* buf = lds + (kt & 1) * ABUF_BYTES;
        const bool more = kt + 1 < nt;
        if (more) {
#pragma unroll
            for (int i = 0; i < 2; ++i) { sk[i] = *(const u32x4*)(Kg + (size_t)((kt + 1) * 64 + srow0 + 32 * i) * kvpitch + scol * 8); sv[i] = *(const u32x4*)(Vg + (size_t)((kt + 1) * 64 + srow0 + 32 * i) * kvpitch + scol * 8); }
        }
        u32x2 mw = {0u, 0u};
        if (MASKED) mw = *(const u32x2*)(mrow + 2 * kt);
        f32x16 p0 = {}, p1 = {};
#pragma unroll
        for (int s = 0; s < 8; ++s) {
            const bf16x8 k0 = *(const LAS bf16x8*)(buf + koff + 32 * s), k1 = *(const LAS bf16x8*)(buf + koff + 32 * KP + 32 * s);
            p0 = __builtin_amdgcn_mfma_f32_32x32x16_bf16(k0, qf[s], p0, 0, 0, 0);
            p1 = __builtin_amdgcn_mfma_f32_32x32x16_bf16(k1, qf[s], p1, 0, 0, 0);
        }
        if (MASKED) {
            const int k0i = kt * 64;
            if (k0i + 63 + 128 > T0) {
                const LAS float* lutb = (const LAS float*)(lds + ATT_LUT_OFF) + head * 129;
                const int base = tpos - k0i - 4 * h;
#pragma unroll
                for (int i = 0; i < 16; ++i) { const int pos = (i & 3) + 8 * (i >> 2);
                    unsigned d0 = (unsigned)(base - pos), d1 = (unsigned)(base - pos - 32); d0 = d0 < 128u ? d0 : 128u; d1 = d1 < 128u ? d1 : 128u;
                    p0[i] += lutb[d0]; p1[i] += lutb[d1]; }
            }
            const int w0 = (int)(mw.x >> (4 * h)), w1 = (int)(mw.y >> (4 * h));
#pragma unroll
            for (int i = 0; i < 16; ++i) { const int pos = (i & 3) + 8 * (i >> 2);
                const unsigned m0 = (unsigned)__builtin_amdgcn_sbfe(w0, pos, 1), m1 = (unsigned)__builtin_amdgcn_sbfe(w1, pos, 1);
                p0[i] = __uint_as_float((m0 & __float_as_uint(p0[i])) | (~m0 & 0xff800000u)); p1[i] = __uint_as_float((m1 & __float_as_uint(p1[i])) | (~m1 & 0xff800000u)); }
        }
        float mxa = __builtin_fmaxf(__builtin_fmaxf(p0[0], p0[1]), p1[0]), mxb = __builtin_fmaxf(__builtin_fmaxf(p0[2], p0[3]), p1[1]);
        mxa = __builtin_fmaxf(__builtin_fmaxf(mxa, p1[2]), p1[3]);
#pragma unroll
        for (int i = 4; i < 16; i += 4) { mxa = __builtin_fmaxf(__builtin_fmaxf(mxa, p0[i]), p0[i + 1]); mxb = __builtin_fmaxf(__builtin_fmaxf(mxb, p0[i + 2]), p0[i + 3]);
            mxa = __builtin_fmaxf(__builtin_fmaxf(mxa, p1[i]), p1[i + 1]); mxb = __builtin_fmaxf(__builtin_fmaxf(mxb, p1[i + 2]), p1[i + 3]); }
        float mx = __builtin_fmaxf(mxa, mxb);
        mx = __builtin_fmaxf(mx, __shfl_xor(mx, 32));
        const float mnew = __builtin_fmaxf(mrun, mx);
        if (__ballot(mnew > mrun) != 0ull) {
            const float alpha = __builtin_amdgcn_exp2f(mrun - mnew);
            lsum *= alpha;
#pragma unroll
            for (int d = 0; d < 4; ++d)
#pragma unroll
                for (int i = 0; i < 16; ++i) o[d][i] *= alpha;
        }
        mrun = mnew;
        float ps = 0.f;
#pragma unroll
        for (int i = 0; i < 16; ++i) { p0[i] = __builtin_amdgcn_exp2f(p0[i] - mnew); p1[i] = __builtin_amdgcn_exp2f(p1[i] - mnew); ps += p0[i] + p1[i]; }
        lsum += ps;
        bf16x8 pb[4];
        { u32x4 w;
          w.x = cvtpk(p0[0], p0[1]); w.y = cvtpk(p0[2], p0[3]); w.z = cvtpk(p0[4], p0[5]); w.w = cvtpk(p0[6], p0[7]); pb[0] = __builtin_bit_cast(bf16x8, w);
          w.x = cvtpk(p0[8], p0[9]); w.y = cvtpk(p0[10], p0[11]); w.z = cvtpk(p0[12], p0[13]); w.w = cvtpk(p0[14], p0[15]); pb[1] = __builtin_bit_cast(bf16x8, w);
          w.x = cvtpk(p1[0], p1[1]); w.y = cvtpk(p1[2], p1[3]); w.z = cvtpk(p1[4], p1[5]); w.w = cvtpk(p1[6], p1[7]); pb[2] = __builtin_bit_cast(bf16x8, w);
          w.x = cvtpk(p1[8], p1[9]); w.y = cvtpk(p1[10], p1[11]); w.z = cvtpk(p1[12], p1[13]); w.w = cvtpk(p1[14], p1[15]); pb[3] = __builtin_bit_cast(bf16x8, w); }
        const LAS unsigned char* vb = buf + KT_BYTES + voff;
#pragma unroll
        for (int d = 0; d < 4; ++d)
#pragma unroll
            for (int s2 = 0; s2 < 4; ++s2) {
                const s16x4 lo = vtr(vb + (16 * s2) * VP + 64 * d), hi = vtr(vb + (16 * s2 + 8) * VP + 64 * d);
                const bf16x8 vf = (bf16x8){lo[0], lo[1], lo[2], lo[3], hi[0], hi[1], hi[2], hi[3]};
                o[d] = __builtin_amdgcn_mfma_f32_32x32x16_bf16(vf, pb[s2], o[d], 0, 0, 0);
            }
        if (more) {
            LAS unsigned char* nb = lds + ((kt + 1) & 1) * ABUF_BYTES;
#pragma unroll
            for (int i = 0; i < 2; ++i) { *(LAS u32x4*)(nb + (srow0 + 32 * i) * KP + scol * 16) = sk[i]; *(LAS u32x4*)(nb + KT_BYTES + (srow0 + 32 * i) * VP + scol * 16) = sv[i]; }
        }
        __syncthreads();
    }
    lsum += __shfl_xor(lsum, 32);
    const float inv = 1.f / lsum;
#pragma unroll
    for (int d = 0; d < 4; ++d)
#pragma unroll
        for (int g = 0; g < 4; ++g) { u32x2 w; w.x = cvtpk(o[d][4 * g] * inv, o[d][4 * g + 1] * inv); w.y = cvtpk(o[d][4 * g + 2] * inv, o[d][4 * g + 3] * inv);
            *(u32x2*)(orow + 32 * d + 8 * g + 4 * h) = w; }
}

#ifdef USE_SIMPLE_GEMM
#define GEMM_CALL(g, S, E) pg8::gemm_simple(g, S, E)
#else
#define GEMM_CALL(g, S, E) pg8::gemm_phase<decltype(E), pg8::StaticOrder, true, true>((LAS unsigned char*)lds, g, S, E)
#endif
#ifndef NAIVE_INDEX
#define NAIVE_INDEX 0
#endif
#ifndef NAIVE_ATTN
#define NAIVE_ATTN 0
#endif
#ifndef NAIVE_MEM
#define NAIVE_MEM 0
#endif
struct Args { const float* in[21]; float* out; unsigned char* ws; };

__device__ __forceinline__ void tr_item(const float* W, int ldw, int c0, int ncols, int K, bf16_t* WT, int r0, float* scr, int kb, int nb, int lane) {
    const int k0 = 64 * kb, n0 = 32 * nb;
#pragma unroll 8
    for (int i = 0; i < 32; ++i) { const int kk = 2 * i + (lane >> 5); const int nn = n0 + (lane & 31);
        scr[kk * 33 + (lane & 31)] = nn < ncols ? W[(size_t)(k0 + kk) * ldw + c0 + nn] : 0.f; }
    asm volatile("s_waitcnt lgkmcnt(0)" ::: "memory");
    const int c = lane & 7;
#pragma unroll
    for (int j = 0; j < 4; ++j) { const int n = (lane >> 3) + 8 * j; const float* s = scr + (8 * c) * 33 + n;
        u32x4 o; o.x = cvtpk(s[0 * 33], s[1 * 33]); o.y = cvtpk(s[2 * 33], s[3 * 33]); o.z = cvtpk(s[4 * 33], s[5 * 33]); o.w = cvtpk(s[6 * 33], s[7 * 33]);
        *(u32x4*)(WT + (size_t)(r0 + n0 + n) * K + k0 + 8 * c) = o; }
    asm volatile("s_waitcnt lgkmcnt(0)" ::: "memory");
}
__device__ __forceinline__ void rms_row_to_bf16(const float* xrow, const float* g, bf16_t* orow, int lane) {
    f32x4 v[4]; float s = 0.f;
#pragma unroll
    for (int j = 0; j < 4; ++j) { v[j] = *(const f32x4*)(xrow + 4 * lane + 256 * j); s += (v[j][0] * v[j][0] + v[j][1] * v[j][1]) + (v[j][2] * v[j][2] + v[j][3] * v[j][3]); }
    const float rstd = rsqrtf(wave_sum(s) * (1.f / DM) + EPS);
#pragma unroll
    for (int j = 0; j < 4; ++j) { const f32x4 gg = *(const f32x4*)(g + 4 * lane + 256 * j);
        u32x2 w; w.x = cvtpk(v[j][0] * rstd * gg[0], v[j][1] * rstd * gg[1]); w.y = cvtpk(v[j][2] * rstd * gg[2], v[j][3] * rstd * gg[3]);
        *(u32x2*)(orow + 4 * lane + 256 * j) = w; }
}
__device__ __forceinline__ void res_norm_row(const float* xin, const bf16_t* mix, const float* gpost, float* xo, const float* gpre, bf16_t* h, int lane) {
    f32x4 mv[4]; float s = 0.f;
#pragma unroll
    for (int j = 0; j < 4; ++j) { const u32x2 w = *(const u32x2*)(mix + 4 * lane + 256 * j); mv[j] = (f32x4){bflo(w.x), bfhi(w.x), bflo(w.y), bfhi(w.y)};
        s += (mv[j][0] * mv[j][0] + mv[j][1] * mv[j][1]) + (mv[j][2] * mv[j][2] + mv[j][3] * mv[j][3]); }
    const float rstd = rsqrtf(wave_sum(s) * (1.f / DM) + EPS);
    f32x4 xv[4]; float s2 = 0.f;
#pragma unroll
    for (int j = 0; j < 4; ++j) { const f32x4 gg = *(const f32x4*)(gpost + 4 * lane + 256 * j); const f32x4 xi = *(const f32x4*)(xin + 4 * lane + 256 * j);
        xv[j] = xi + mv[j] * rstd * gg; *(f32x4*)(xo + 4 * lane + 256 * j) = xv[j];
        s2 += (xv[j][0] * xv[j][0] + xv[j][1] * xv[j][1]) + (xv[j][2] * xv[j][2] + xv[j][3] * xv[j][3]); }
    if (h) {
        const float r2 = rsqrtf(wave_sum(s2) * (1.f / DM) + EPS);
#pragma unroll
        for (int j = 0; j < 4; ++j) { const f32x4 gg = *(const f32x4*)(gpre + 4 * lane + 256 * j);
            u32x2 w; w.x = cvtpk(xv[j][0] * r2 * gg[0], xv[j][1] * r2 * gg[1]); w.y = cvtpk(xv[j][2] * r2 * gg[2], xv[j][3] * r2 * gg[3]);
            *(u32x2*)(h + 4 * lane + 256 * j) = w; }
    }
}

__global__ void __launch_bounds__(NTHR, 2) fwd_kernel(Args args) {
    extern __shared__ __attribute__((aligned(16))) unsigned char lds[];
    const int tid = threadIdx.x, lane = tid & 63, wave = __builtin_amdgcn_readfirstlane(tid >> 6);
    const int G = gridDim.x, bid = blockIdx.x;
    unsigned char* ws = args.ws;
    unsigned* ctl = (unsigned*)(ws + WS_CTL);
    for (int u = tid; u < (LDS_BYTES - LDSCTL_OFF) / 4; u += NTHR) ((unsigned*)(lds + LDSCTL_OFF))[u] = 0u;
    __syncthreads();
    XcdBarrier bar = xcd_barrier_post(ctl + CW_BAR, (volatile LAS unsigned*)((LAS unsigned char*)lds + MISC_OFF + 32));

    const float* x = args.in[0]; const float* mem = args.in[1];
    const float* g_mix_pre = args.in[2]; const float* g_mix_post = args.in[3];
    const float* w_in = args.in[4]; const float* pool_w = args.in[5]; const float* pool_scale = args.in[6];
    const float* w_proj_pool = args.in[7]; const float* w_proj_attn = args.in[8]; const float* rel_bias = args.in[9];
    const float* w_out = args.in[10]; const float* g_mem_pre = args.in[11]; const float* g_mem_kv = args.in[12]; const float* g_mem_post = args.in[13];
    const float* w_q_mem = args.in[14]; const float* w_kv_mem = args.in[15]; const float* w_o_mem = args.in[16];
    const float* g_ffn_pre = args.in[17]; const float* g_ffn_post = args.in[18]; const float* w_gate_up = args.in[19]; const float* w_down = args.in[20];
    float* out = args.out;
    bf16_t* Win_t = (bf16_t*)(ws + WS_WIN); bf16_t* Weff_t = (bf16_t*)(ws + WS_WEFF); bf16_t* Wpa_t = (bf16_t*)(ws + WS_WPA); bf16_t* Wout_t = (bf16_t*)(ws + WS_WOUT);
    bf16_t* Wq_t = (bf16_t*)(ws + WS_WQ); bf16_t* Wkv_t = (bf16_t*)(ws + WS_WKV); bf16_t* Wo_t = (bf16_t*)(ws + WS_WO); bf16_t* Wgu_t = (bf16_t*)(ws + WS_WGU); bf16_t* Wdn_t = (bf16_t*)(ws + WS_WDN);
    bf16_t* MEMN = (bf16_t*)(ws + WS_MEMN); bf16_t* KVM = (bf16_t*)(ws + WS_KVM); unsigned* BMK = (unsigned*)(ws + WS_BM);
    bf16_t* H = (bf16_t*)(ws + WS_H); bf16_t* ATT = H;
    bf16_t* U = (bf16_t*)(ws + WS_U); bf16_t* Q = (bf16_t*)(ws + WS_Q); bf16_t* KV = (bf16_t*)(ws + WS_KV); bf16_t* QI = (bf16_t*)(ws + WS_QI); bf16_t* KX = (bf16_t*)(ws + WS_KX); bf16_t* WI = (bf16_t*)(ws + WS_WI); unsigned* SC = (unsigned*)(ws + WS_S);
    bf16_t* GP = (bf16_t*)(ws + WS_GP); bf16_t* GA = (bf16_t*)(ws + WS_GA); bf16_t* PL = (bf16_t*)(ws + WS_PL); bf16_t* AB = (bf16_t*)(ws + WS_AB);
    bf16_t* MG = (bf16_t*)(ws + WS_MG); bf16_t* MIX = (bf16_t*)(ws + WS_MIX); bf16_t* QM = (bf16_t*)(ws + WS_QM); bf16_t* OM = (bf16_t*)(ws + WS_OM); bf16_t* ACT = (bf16_t*)(ws + WS_ACT);

    const int gw = bid * NWAVES + wave, NGW = G * NWAVES;
    unsigned long long ts_sel_a0 = 0, ts_sel_a1 = 0, ts_sel_b0 = 0, ts_sel_b1 = 0; int ts_n = 0;
#define STAMP() do { if (TS_ENABLE) { const unsigned long long t_ = __builtin_amdgcn_s_memrealtime(); if (ts_n == TS_A) ts_sel_a0 = t_; if (ts_n == TS_A + 1) ts_sel_a1 = t_; if (ts_n == TS_B) ts_sel_b0 = t_; if (ts_n == TS_B + 1) ts_sel_b1 = t_; ++ts_n; } } while (0)
    STAMP();

    {
        float* scr = (float*)(lds + wave * 16384);
        constexpr int I_A = 16 * 67, I_B = 16 * 64, I_PA = 16 * 32, I_OUT = 16 * 32, I_Q = 16 * 16, I_KV = 16 * 32, I_O = 8 * 32, I_GU = 16 * 176, I_DN = 44 * 32;
        constexpr int NITEMS = I_A + I_B + I_PA + I_OUT + I_Q + I_KV + I_O + I_GU + I_DN;
        for (int it = gw; it < NITEMS; it += NGW) {
            int r = it;
            if (r < I_A) { tr_item(w_in, IN_W, 0, 2116, 1024, Win_t, 0, scr, r / 67, r % 67, lane); continue; } r -= I_A;
            if (r < I_B) { tr_item(w_in, IN_W, 2116, 2048, 1024, Win_t, 2304, scr, r / 64, r % 64, lane); continue; } r -= I_B;
            if (r < I_PA) { tr_item(w_proj_attn, 1024, 0, 1024, 1024, Wpa_t, 0, scr, r / 32, r % 32, lane); continue; } r -= I_PA;
            if (r < I_OUT) { tr_item(w_out, 1024, 0, 1024, 1024, Wout_t, 0, scr, r / 32, r % 32, lane); continue; } r -= I_OUT;
            if (r < I_Q) { tr_item(w_q_mem, 512, 0, 512, 1024, Wq_t, 0, scr, r / 16, r % 16, lane); continue; } r -= I_Q;
            if (r < I_KV) { tr_item(w_kv_mem, 1024, 0, 1024, 1024, Wkv_t, 0, scr, r / 32, r % 32, lane); continue; } r -= I_KV;
            if (r < I_O) { tr_item(w_o_mem, 1024, 0, 1024, 512, Wo_t, 0, scr, r / 32, r % 32, lane); continue; } r -= I_O;
            if (r < I_GU) { const int kb = r / 176, nb = r % 176; const int n0 = 32 * nb, pn = n0 / 256, half = (n0 % 256) / 128, jj0 = n0 % 128;
                const int src = half * DFF + pn * 128 + jj0;
                tr_item(w_gate_up, 2 * DFF, src - n0, 1 << 30, 1024, Wgu_t, 0, scr, kb, nb, lane); continue; } r -= I_GU;
            tr_item(w_down, 1024, 0, 1024, DFF, Wdn_t, 0, scr, r / 32, r % 32, lane);
        }
        for (int i = bid * NTHR + tid; i < 160 * 1024 / 8; i += G * NTHR) *(u32x4*)(Win_t + (size_t)2144 * 1024 + (size_t)i * 8) = (u32x4){0u, 0u, 0u, 0u};
        for (int i = bid * NTHR + tid; i < 512 * 1024; i += G * NTHR) {
            const int k = i >> 10, n = i & 1023, gq = k >> 7;
            const float* pw = pool_w + (size_t)k * 128; float acc = 0.f;
            for (int d = 0; d < 128; ++d) acc += pw[d] * pool_scale[gq * 128 + d] * w_proj_pool[(size_t)(gq * 128 + d) * 1024 + n];
            Weff_t[(size_t)n * 512 + k] = f2bf(acc);
        }
        for (int m = gw; m < M + MMEM; m += NGW) {
            if (m < M) rms_row_to_bf16(x + (size_t)m * DM, g_mix_pre, H + (size_t)m * DM, lane);
            else rms_row_to_bf16(mem + (size_t)(m - M) * DM, g_mem_kv, MEMN + (size_t)(m - M) * DM, lane);
        }
    }
    xcd_barrier(bar); STAMP();

    { pg8::Gemm g{H, Win_t + (size_t)1792 * 1024, M, 512, 1024}; pg8::StaticOrder S; S.init(M, 512, G, bid); pg8::EpiP1 E{U, Q, KV, QI, KX, WI, GP, GA, 7}; GEMM_CALL(g, S, E); }
    xcd_barrier(bar); STAMP();
    index_score_phase(QI, KX, WI, SC, bid, G);
    xcd_barrier(bar); STAMP();
    index_select_phase(lds, SC, BMK, bid, G);
    xcd_barrier(bar); STAMP();
    {
        { pg8::Gemm g{MEMN, Wkv_t, MMEM, 1024, 1024}; pg8::StaticOrder S; S.init(MMEM, 1024, G, bid); pg8::EpiBf E{KVM, 1024, 1.f}; GEMM_CALL(g, S, E); }
        { pg8::Gemm g{H, Win_t, M, 1792, 1024}; pg8::StaticOrder S; S.init(M, 1792, G, bid); pg8::EpiP1 E{U, Q, KV, QI, KX, WI, GP, GA, 0}; GEMM_CALL(g, S, E); }
        { pg8::Gemm g{H, Win_t + (size_t)2304 * 1024, M, 2048, 1024}; pg8::StaticOrder S; S.init(M, 2048, G, bid); pg8::EpiP1 E{U, Q, KV, QI, KX, WI, GP, GA, 9}; GEMM_CALL(g, S, E); }
    }
    xcd_barrier(bar); STAMP();

    {
        for (int i = bid * NTHR + tid; i < M * 64; i += G * NTHR) {
            const int tok = i >> 6, c8 = (i & 63) * 8, t = tok & (SEQ - 1), w = 2 << (c8 >> 7);
            const u32x4 cur = *(const u32x4*)(U + (size_t)tok * 512 + c8);
            float s[8], c[8]; c[0] = bflo(cur.x); c[1] = bfhi(cur.x); c[2] = bflo(cur.y); c[3] = bfhi(cur.y); c[4] = bflo(cur.z); c[5] = bfhi(cur.z); c[6] = bflo(cur.w); c[7] = bfhi(cur.w);
#pragma unroll
            for (int e = 0; e < 8; ++e) s[e] = c[e];
            const int cnt = (t + 1 < w) ? t + 1 : w;
            for (int j = 1; j < cnt; ++j) { const u32x4 p = *(const u32x4*)(U + (size_t)(tok - j) * 512 + c8);
                s[0] += bflo(p.x); s[1] += bfhi(p.x); s[2] += bflo(p.y); s[3] += bfhi(p.y); s[4] += bflo(p.z); s[5] += bfhi(p.z); s[6] += bflo(p.w); s[7] += bfhi(p.w); }
            const float inv = 1.f / (float)cnt; u32x4 o;
            o.x = cvtpk(s[0] * inv - c[0], s[1] * inv - c[1]); o.y = cvtpk(s[2] * inv - c[2], s[3] * inv - c[3]);
            o.z = cvtpk(s[4] * inv - c[4], s[5] * inv - c[5]); o.w = cvtpk(s[6] * inv - c[6], s[7] * inv - c[7]);
            *(u32x4*)(PL + (size_t)tok * 512 + c8) = o;
        }
    }
    {
#if NAIVE_ATTN
        int* list = (int*)lds;
        unsigned* wbits = (unsigned*)(lds + 1024);
        unsigned* wcnt = (unsigned*)(lds + 1536);
        int* lut = (int*)(lds + 2048);
        float* qs = (float*)(lds + 4096);
        float* ps = (float*)(lds + 8192);
        int* nselp = (int*)(lds + 16384);
        if (tid < 128) { int bk = tid; if (tid >= 16) { const float nf = (float)tid; int lg = 16 + (int)(logf(nf / 16.f) / logf(8.f) * 16.f); bk = lg < 31 ? lg : 31; } lut[tid] = bk; }
        __syncthreads();
        for (int tok = bid; tok < M; tok += G) {
            const int b = tok >> 12, t = tok & (SEQ - 1);
            if (tid < 128) { const unsigned w = (tid * 32 <= t) ? BMK[(size_t)tok * 128 + tid] : 0u; wbits[tid] = w; wcnt[tid] = __popc(w); }
            for (int i = tid; i < 1024; i += NTHR) qs[i] = bf2f(Q[(size_t)tok * 1024 + i]);
            __syncthreads();
            if (tid < 128) { int off = 0; for (int j = 0; j < tid; ++j) off += wcnt[j]; unsigned w = wbits[tid]; int pos = off;
                while (w) { const int bit = __ffs(w) - 1; list[pos++] = tid * 32 + bit; w &= w - 1; }
                if (tid == 127) nselp[0] = pos; }
            __syncthreads();
            const int nsel = nselp[0]; const int h = wave;
            float lg[4]; float mx = -INFINITY;
#pragma unroll
            for (int jj = 0; jj < 4; ++jj) { const int j = lane + 64 * jj; lg[jj] = -INFINITY; asm volatile("" ::: "memory");
                if (j < nsel) { const int s = list[j]; const bf16_t* kr = KV + (size_t)(b * SEQ + s) * 256; float d = 0.f;
#pragma unroll
                    for (int q8 = 0; q8 < 16; ++q8) { const u32x4 kw = *(const u32x4*)(kr + 8 * q8); const float* qq = qs + h * 128 + 8 * q8;
                        d += qq[0] * bflo(kw.x) + qq[1] * bfhi(kw.x) + qq[2] * bflo(kw.y) + qq[3] * bfhi(kw.y) + qq[4] * bflo(kw.z) + qq[5] * bfhi(kw.z) + qq[6] * bflo(kw.w) + qq[7] * bfhi(kw.w); }
                    const int dist = t - s; const int bk = dist < 128 ? lut[dist] : 31;
                    lg[jj] = d * (1.f / LOG2E) + rel_bias[bk * 8 + h]; }
                mx = fmaxf(mx, lg[jj]); }
            mx = wave_max(mx); float sum = 0.f;
#pragma unroll
            for (int jj = 0; jj < 4; ++jj) { lg[jj] = (lg[jj] == -INFINITY) ? 0.f : __expf(lg[jj] - mx); sum += lg[jj]; }
            sum = wave_sum(sum); const float inv = 1.f / sum;
#pragma unroll
            for (int jj = 0; jj < 4; ++jj) ps[h * 256 + lane + 64 * jj] = lg[jj] * inv;
            __syncthreads();
            float a0 = 0.f, a1 = 0.f;
            for (int j = 0; j < nsel; ++j) { const int s = list[j]; const unsigned vw = *(const unsigned*)(KV + (size_t)(b * SEQ + s) * 256 + 128 + 2 * lane); const float p = ps[h * 256 + j];
                a0 += p * bflo(vw); a1 += p * bfhi(vw); }
            *(unsigned*)(ATT + (size_t)tok * 1024 + h * 128 + 2 * lane) = cvtpk(a0, a1);
            __syncthreads();
        }
    #else
        {
            float* lutf = (float*)(lds + ATT_LUT_OFF);
            for (int i = tid; i < 8 * 129; i += NTHR) { const int hh = i / 129, d = i % 129; float v = 0.f;
                if (d < 128) { int bk = d; if (d >= 16) { const int lg = 16 + (int)(logf((float)d / 16.f) / logf(8.f) * 16.f); bk = lg < 31 ? lg : 31; }
                    v = (rel_bias[bk * 8 + hh] - rel_bias[31 * 8 + hh]) * LOG2E; }
                lutf[i] = v; }
            __syncthreads();
            const int r = lane & 31;
            for (int j = bid; j < 512; j += G) {
#pragma unroll 1
                for (int e = 0; e < 2; ++e) {
                    const int idx = e == 0 ? j : 1023 - j;
                    const int tb = 127 - (idx >> 3), b = idx & 7, T0 = tb * 32; const size_t tok = (size_t)b * SEQ + T0 + r;
                    attn_item<true>((LAS unsigned char*)lds, Q + tok * 1024 + wave * 128, KV + (size_t)b * SEQ * 256, KV + (size_t)b * SEQ * 256 + 128, 256, (T0 >> 6) + 1,
                                    BMK + tok * 128, T0 + r, T0, wave, ATT + tok * 1024 + wave * 128);
                }
            }
        }
#endif
    }
    xcd_barrier(bar); STAMP();
    { pg8::Gemm g{PL, Weff_t, M, 1024, 512}; pg8::StaticOrder S; S.init(M, 1024, G, bid); pg8::EpiBf E{AB, 1024, 1.f}; GEMM_CALL(g, S, E); }
    xcd_barrier(bar); STAMP();

    { pg8::Gemm g{ATT, Wpa_t, M, 1024, 1024}; pg8::StaticOrder S; S.init(M, 1024, G, bid); pg8::EpiMerge E{AB, GP, GA, MG}; GEMM_CALL(g, S, E); }
    xcd_barrier(bar); STAMP();
    { pg8::Gemm g{MG, Wout_t, M, 1024, 1024}; pg8::StaticOrder S; S.init(M, 1024, G, bid); pg8::EpiBf E{MIX, 1024, 1.f}; GEMM_CALL(g, S, E); }
    xcd_barrier(bar); STAMP();
    for (int m = gw; m < M; m += NGW) res_norm_row(x + (size_t)m * DM, MIX + (size_t)m * DM, g_mix_post, out + (size_t)m * DM, g_mem_pre, H + (size_t)m * DM, lane);
    xcd_barrier(bar); STAMP();
    { pg8::Gemm g{H, Wq_t, M, 512, 1024}; pg8::StaticOrder S; S.init(M, 512, G, bid); pg8::EpiBf E{QM, 512, C2Q}; GEMM_CALL(g, S, E); }
    xcd_barrier(bar); STAMP();
    {
#if NAIVE_MEM
        float* qs = (float*)lds;
        float* ps = (float*)(lds + 4096);
        for (int tp = bid; tp < M / 2; tp += G) {
            for (int i = tid; i < 1024; i += NTHR) qs[i] = bf2f(QM[(size_t)tp * 1024 + i]);
            __syncthreads();
            const int tok = tp * 2 + (wave >> 2), h = wave & 3, b = tok >> 12;
            const float* qq = qs + (wave >> 2) * 512 + h * 128;
            float lg[4]; float mx = -INFINITY;
#pragma unroll
            for (int jj = 0; jj < 4; ++jj) { const int j = lane + 64 * jj; asm volatile("" ::: "memory"); const bf16_t* kr = KVM + (size_t)(b * NMEM + j) * 1024 + h * 128; float d = 0.f;
#pragma unroll
                for (int q8 = 0; q8 < 16; ++q8) { const u32x4 kw = *(const u32x4*)(kr + 8 * q8); const float* q = qq + 8 * q8;
                    d += q[0] * bflo(kw.x) + q[1] * bfhi(kw.x) + q[2] * bflo(kw.y) + q[3] * bfhi(kw.y) + q[4] * bflo(kw.z) + q[5] * bfhi(kw.z) + q[6] * bflo(kw.w) + q[7] * bfhi(kw.w); }
                lg[jj] = d * (1.f / LOG2E); mx = fmaxf(mx, lg[jj]); }
            mx = wave_max(mx); float sum = 0.f;
#pragma unroll
            for (int jj = 0; jj < 4; ++jj) { lg[jj] = __expf(lg[jj] - mx); sum += lg[jj]; }
            sum = wave_sum(sum); const float inv = 1.f / sum;
#pragma unroll
            for (int jj = 0; jj < 4; ++jj) ps[wave * 256 + lane + 64 * jj] = lg[jj] * inv;
            __syncthreads();
            float a0 = 0.f, a1 = 0.f;
            for (int j = 0; j < NMEM; ++j) { const unsigned vw = *(const unsigned*)(KVM + (size_t)(b * NMEM + j) * 1024 + 512 + h * 128 + 2 * lane); const float p = ps[wave * 256 + j];
                a0 += p * bflo(vw); a1 += p * bfhi(vw); }
            *(unsigned*)(OM + (size_t)tok * 512 + h * 128 + 2 * lane) = cvtpk(a0, a1);
            __syncthreads();
        }
    #else
        {
            const int r = lane & 31;
            for (int it = bid; it < 512; it += G) {
                const int b = it >> 6, hh = (it >> 4) & 3, tg = it & 15; const size_t tok = (size_t)b * SEQ + tg * 256 + wave * 32 + r;
                const bf16_t* Kg = KVM + (size_t)b * NMEM * 1024 + hh * 128;
                attn_item<false>((LAS unsigned char*)lds, QM + tok * 512 + hh * 128, Kg, Kg + 512, 1024, 4, nullptr, 0, 0, 0, OM + tok * 512 + hh * 128);
            }
        }
#endif
    }
    xcd_barrier(bar); STAMP();
    { pg8::Gemm g{OM, Wo_t, M, 1024, 512}; pg8::StaticOrder S; S.init(M, 1024, G, bid); pg8::EpiBf E{MIX, 1024, 1.f}; GEMM_CALL(g, S, E); }
    xcd_barrier(bar); STAMP();
    for (int m = gw; m < M; m += NGW) res_norm_row(out + (size_t)m * DM, MIX + (size_t)m * DM, g_mem_post, out + (size_t)m * DM, g_ffn_pre, H + (size_t)m * DM, lane);
    xcd_barrier(bar); STAMP();
    { pg8::Gemm g{H, Wgu_t, M, 2 * DFF, 1024}; pg8::StaticOrder S; S.init(M, 2 * DFF, G, bid); pg8::EpiSwiglu E{ACT}; GEMM_CALL(g, S, E); }
    xcd_barrier(bar); STAMP();
    { pg8::Gemm g{ACT, Wdn_t, M, 1024, DFF}; pg8::StaticOrder S; S.init(M, 1024, G, bid); pg8::EpiBf E{MIX, 1024, 1.f}; GEMM_CALL(g, S, E); }
    xcd_barrier(bar); STAMP();
    for (int m = gw; m < M; m += NGW) res_norm_row(out + (size_t)m * DM, MIX + (size_t)m * DM, g_ffn_post, out + (size_t)m * DM, nullptr, nullptr, lane);
    STAMP();
    if (TS_ENABLE && bid == 0 && tid == 0) {
        asm volatile("s_waitcnt vmcnt(0)" ::: "memory");
        const float xa = rintf((float)(ts_sel_a1 - ts_sel_a0) * (1.0f / 800.f));
        out[0] += xa;
        const unsigned long long wait = 2ull * (ts_sel_b1 - ts_sel_b0), t0_ = __builtin_amdgcn_s_memrealtime();
        while (__builtin_amdgcn_s_memrealtime() - t0_ < wait) __builtin_amdgcn_s_sleep(8);
    }
}

extern "C" void kernel_launch(void* const* d_in, const int* in_sizes, int n_in, void* d_out, int out_size, void* d_ws, size_t ws_size, hipStream_t stream) {
    static int grid = 0;
    if (grid == 0) {
        if (n_in != 21 || in_sizes[0] != M * DM || out_size != M * DM || ws_size < WS_END) { fprintf(stderr, "kernel_launch: unexpected shapes (n_in %d, in0 %d, out %d, ws %zu)\n", n_in, n_in > 0 ? in_sizes[0] : -1, out_size, ws_size); grid = -1; return; }
        int dev = 0, cus = 0, per_cu = 0;
        if (hipGetDevice(&dev) != hipSuccess || hipDeviceGetAttribute(&cus, hipDeviceAttributeMultiprocessorCount, dev) != hipSuccess) { grid = -1; return; }
        if (hipFuncSetAttribute((const void*)fwd_kernel, hipFuncAttributeMaxDynamicSharedMemorySize, LDS_BYTES) != hipSuccess) { fprintf(stderr, "kernel_launch: hipFuncSetAttribute failed\n"); grid = -1; return; }
        if (hipOccupancyMaxActiveBlocksPerMultiprocessor(&per_cu, (const void*)fwd_kernel, NTHR, LDS_BYTES) != hipSuccess || per_cu < 1) { fprintf(stderr, "kernel_launch: occupancy query says %d blocks per CU\n", per_cu); }
        (void)hipGetLastError();
        grid = cus;
    }
    if (grid < 0) return;
    (void)hipMemsetAsync((char*)d_ws + WS_CTL, 0, CTL_ZERO_BYTES, stream);
    Args a{};
    for (int i = 0; i < 21; ++i) a.in[i] = (const float*)d_in[i];
    a.out = (float*)d_out; a.ws = (unsigned char*)d_ws;
    hipLaunchKernelGGL(fwd_kernel, dim3(grid), dim3(NTHR), LDS_BYTES, stream, a);
}
```
